# Optimizing an MI355X kernel written in HIP

```python
import jax
import jax.numpy as jnp
from jax import lax
import numpy as np

D_MODEL = 1024
BATCH = 16
SEQ = 4096
DEPTH = 1

M_HEADS = 4
M_HEAD_DIM = D_MODEL // M_HEADS
M_WIDTH = M_HEADS * M_HEAD_DIM
M_CHUNK = 64
CONV_WIDTH = 4
A_HEAD_DIM = 64
A_HEADS = D_MODEL // A_HEAD_DIM
A_KV_HEADS = max(1, A_HEADS // 8)
A_GROUP = A_HEADS // A_KV_HEADS
A_WIDTH = A_HEADS * A_HEAD_DIM
A_KV_WIDTH = A_KV_HEADS * A_HEAD_DIM
WINDOW = 128
A_BLOCK = WINDOW
ROPE_THETA = 500000.0
ROPE_DIM = A_HEAD_DIM // 4
D_FF = 256 * (-(-8 * D_MODEL // (3 * 256)))
EPS = 1e-6
IN_SIZES = (M_WIDTH, M_WIDTH, M_WIDTH, M_WIDTH, M_HEADS, M_HEADS,
            A_WIDTH, A_KV_WIDTH, A_KV_WIDTH, D_MODEL, D_MODEL)
IN_OFFSETS = tuple(int(o) for o in np.cumsum(IN_SIZES)[:-1])
N_IN = int(sum(IN_SIZES))

kernel_name = 'hybrid_mlstm_swa_sinks_gated'


def rms_norm(x, g):
    xf = x.astype(jnp.float32)
    y = xf * lax.rsqrt(jnp.mean(xf * xf, axis=-1, keepdims=True) + EPS)
    return (y * g.astype(jnp.float32)).astype(x.dtype)


def partial_rope(x, pos):
    half = ROPE_DIM // 2
    inv_freq = ROPE_THETA ** (-jnp.arange(half, dtype=jnp.float32) * (2.0 / ROPE_DIM))
    ang = pos.astype(jnp.float32)[:, None] * inv_freq[None, :]
    cos = jnp.cos(ang)[:, None, :]
    sin = jnp.sin(ang)[:, None, :]
    xr = x[..., :ROPE_DIM].astype(jnp.float32)
    x1, x2 = xr[..., :half], xr[..., half:]
    rot = jnp.concatenate([x1 * cos - x2 * sin, x2 * cos + x1 * sin], axis=-1).astype(x.dtype)
    return jnp.concatenate([rot, x[..., ROPE_DIM:]], axis=-1)


def causal_depthwise_conv(x, w, b):
    y = lax.conv_general_dilated(
        x, w[:, None, :].astype(x.dtype), window_strides=(1,),
        padding=((CONV_WIDTH - 1, 0),), dimension_numbers=('NWC', 'WIO', 'NWC'),
        feature_group_count=x.shape[-1])
    return y + b.astype(x.dtype)


def mlstm_chunkwise(q, k, v, i_pre, f_pre):
    B, S, H, d = q.shape
    L = M_CHUNK
    NC = S // L
    k = k * (d ** -0.5)
    log_f = jax.nn.log_sigmoid(f_pre)

    def to_chunks(t):
        return t.reshape(B, NC, L, H, d).transpose(1, 0, 3, 2, 4)

    def gate_chunks(t):
        return t.reshape(B, NC, L, H).transpose(1, 0, 3, 2)

    causal = jnp.tril(jnp.ones((L, L), dtype=bool))

    def step(carry, inp):
        C, n, m = carry
        qc, kc, vc, ic, fc = inp
        b = jnp.cumsum(fc, axis=-1)
        log_d = b[..., :, None] - b[..., None, :] + ic[..., None, :]
        log_d = jnp.where(causal, log_d, -jnp.inf)
        m_inter = b + m[..., None]
        m_t = jnp.maximum(m_inter, jnp.max(log_d, axis=-1))
        scores = jnp.einsum('bhtd,bhsd->bhts', qc, kc) * jnp.exp(log_d - m_t[..., None])
        inter_scale = jnp.exp(m_inter - m_t)
        num = (jnp.einsum('bhts,bhse->bhte', scores, vc)
               + inter_scale[..., None] * jnp.einsum('bhtd,bhde->bhte', qc, C))
        den = jnp.sum(scores, axis=-1) + inter_scale * jnp.einsum('bhtd,bhd->bht', qc, n)
        h = num / jnp.maximum(jnp.abs(den), jnp.exp(-m_t))[..., None]
        b_last = b[..., -1]
        w = b_last[..., None] - b + ic
        m_new = jnp.maximum(b_last + m, jnp.max(w, axis=-1))
        decay = jnp.exp(b_last + m - m_new)
        kw = kc * jnp.exp(w - m_new[..., None])[..., None]
        C = decay[..., None, None] * C + jnp.einsum('bhsd,bhse->bhde', kw, vc)
        n = decay[..., None] * n + jnp.sum(kw, axis=2)
        return (C, n, m_new), h

    init = (jnp.zeros((B, H, d, d), jnp.float32), jnp.zeros((B, H, d), jnp.float32),
            jnp.zeros((B, H), jnp.float32))
    _, h = lax.scan(step, init, (to_chunks(q), to_chunks(k), to_chunks(v),
                                 gate_chunks(i_pre), gate_chunks(log_f)))
    return h.transpose(1, 0, 3, 2, 4).reshape(B, S, H, d)


def swa_gqa_sinks(q, k, v, sinks):
    B, S, H, hd = q.shape
    NB = S // A_BLOCK
    qb = q.reshape(B, NB, A_BLOCK, A_KV_HEADS, A_GROUP, hd)

    def band(t):
        padded = jnp.pad(t, ((0, 0), (A_BLOCK, 0), (0, 0), (0, 0)))
        prev = padded[:, :S].reshape(B, NB, A_BLOCK, A_KV_HEADS, hd)
        cur = t.reshape(B, NB, A_BLOCK, A_KV_HEADS, hd)
        return jnp.concatenate([prev, cur], axis=2)

    kb, vb = band(k), band(v)
    logits = jnp.einsum('bnqkgd,bnskd->bnkgqs', qb, kb,
                        preferred_element_type=jnp.float32) * (hd ** -0.5)
    blk = jnp.arange(NB)[:, None] * A_BLOCK
    qpos = blk + jnp.arange(A_BLOCK)[None, :]
    kpos = blk - A_BLOCK + jnp.arange(2 * A_BLOCK)[None, :]
    rel = qpos[:, :, None] - kpos[:, None, :]
    mask = (rel >= 0) & (rel < WINDOW) & (kpos[:, None, :] >= 0)
    logits = jnp.where(mask[None, :, None, None], logits, -jnp.inf)
    sink = sinks.astype(jnp.float32).reshape(A_KV_HEADS, A_GROUP)[None, None, :, :, None]
    mx = jnp.maximum(jnp.max(logits, axis=-1), sink)
    p = jnp.exp(logits - mx[..., None])
    p = p / (jnp.sum(p, axis=-1) + jnp.exp(sink - mx))[..., None]
    out = jnp.einsum('bnkgqs,bnskd->bnqkgd', p.astype(v.dtype), vb)
    return out.reshape(B, S, H * hd)


def setup_inputs(seed: int = 0) -> dict:
    key = jax.random.key(seed)
    ks = jax.random.split(key, 20)
    f32 = jnp.float32
    nrm = lambda k, shape, scale: jax.random.normal(k, shape, f32) * scale
    gate_bias = jnp.concatenate([
        nrm(ks[4], (DEPTH, M_HEADS), 0.1),
        jnp.broadcast_to(jnp.linspace(3.0, 6.0, M_HEADS, dtype=f32), (DEPTH, M_HEADS))
        + nrm(ks[5], (DEPTH, M_HEADS), 0.01)], axis=-1)
    return {
        'x': nrm(ks[0], (BATCH, SEQ, D_MODEL), 1.0),
        'norm1_g': 1.0 + nrm(ks[1], (DEPTH, D_MODEL), 0.02),
        'w_in': nrm(ks[2], (DEPTH, D_MODEL, N_IN), D_MODEL ** -0.5),
        'conv_w': nrm(ks[3], (DEPTH, CONV_WIDTH, 2 * M_WIDTH), CONV_WIDTH ** -0.5),
        'conv_b': nrm(ks[6], (DEPTH, 2 * M_WIDTH), 0.01),
        'b_mgate': gate_bias,
        'm_norm_g': 1.0 + nrm(ks[7], (DEPTH, M_WIDTH), 0.02),
        'q_norm_g': 1.0 + nrm(ks[8], (DEPTH, A_HEAD_DIM), 0.02),
        'k_norm_g': 1.0 + nrm(ks[9], (DEPTH, A_HEAD_DIM), 0.02),
        'sinks': nrm(ks[10], (DEPTH, A_HEADS), 1.0),
        'b_merge': nrm(ks[11], (DEPTH, 2 * D_MODEL), 0.01),
        'w_branch_m': nrm(ks[12], (DEPTH, M_WIDTH, D_MODEL), M_WIDTH ** -0.5),
        'w_branch_a': nrm(ks[13], (DEPTH, A_WIDTH, D_MODEL), A_WIDTH ** -0.5),
        'w_out': nrm(ks[14], (DEPTH, D_MODEL, D_MODEL), D_MODEL ** -0.5),
        'norm2_g': 1.0 + nrm(ks[15], (DEPTH, D_MODEL), 0.02),
        'w_ffn_in': nrm(ks[16], (DEPTH, D_MODEL, 2 * D_FF), D_MODEL ** -0.5),
        'w_ffn_out': nrm(ks[17], (DEPTH, D_FF, D_MODEL), D_FF ** -0.5),
    }


def reference(x, norm1_g, w_in, conv_w, conv_b, b_mgate, m_norm_g, q_norm_g, k_norm_g,
              sinks, b_merge, w_branch_m, w_branch_a, w_out, norm2_g, w_ffn_in, w_ffn_out):
    B, S, _ = x.shape
    pos = jnp.arange(S)
    for l in range(DEPTH):
        h = rms_norm(x, norm1_g[l])
        proj = h @ w_in[l]
        qk = jax.nn.silu(causal_depthwise_conv(proj[..., :2 * M_WIDTH], conv_w[l], conv_b[l]))
        _, _, mv, mo, mi, mf, aq, ak, av, gm, ga = jnp.split(proj, IN_OFFSETS, axis=-1)
        mq, mk = qk[..., :M_WIDTH], qk[..., M_WIDTH:]
        heads_m = lambda t: t.reshape(B, S, M_HEADS, M_HEAD_DIM).astype(jnp.float32)
        gb = b_mgate[l].astype(jnp.float32)
        h_tilde = mlstm_chunkwise(heads_m(mq), heads_m(mk), heads_m(mv),
                                  mi.astype(jnp.float32) + gb[:M_HEADS],
                                  mf.astype(jnp.float32) + gb[M_HEADS:])
        h_m = jax.nn.sigmoid(heads_m(mo)) * h_tilde
        y_m = rms_norm(h_m, m_norm_g[l].reshape(M_HEADS, M_HEAD_DIM)).reshape(B, S, M_WIDTH).astype(x.dtype)
        q = aq.reshape(B, S, A_HEADS, A_HEAD_DIM)
        k = ak.reshape(B, S, A_KV_HEADS, A_HEAD_DIM)
        v = av.reshape(B, S, A_KV_HEADS, A_HEAD_DIM)
        q = partial_rope(rms_norm(q, q_norm_g[l]), pos)
        k = partial_rope(rms_norm(k, k_norm_g[l]), pos)
        y_a = swa_gqa_sinks(q, k, v, sinks[l])
        g_m = jax.nn.sigmoid(gm + b_merge[l, :D_MODEL])
        g_a = jax.nn.sigmoid(ga + b_merge[l, D_MODEL:])
        merged = g_m * (y_m @ w_branch_m[l]) + g_a * (y_a @ w_branch_a[l])
        x = x + merged @ w_out[l]
        gu = rms_norm(x, norm2_g[l]) @ w_ffn_in[l]
        x = x + (jax.nn.silu(gu[..., :D_FF]) * gu[..., D_FF:]) @ w_ffn_out[l]
    return x
```

```cpp
#include <hip/hip_runtime.h>
#include <cstdio>
#include <cstdint>
namespace pg8 {
#define PG8_LAS __attribute__((address_space(3)))
typedef unsigned short bf16_t;
typedef short bf16x8 __attribute__((ext_vector_type(8)));
typedef float f32x4 __attribute__((ext_vector_type(4)));
typedef unsigned u32x4 __attribute__((ext_vector_type(4)));
constexpr int BM = 256, BK = 64, HALF = 128, HTB = HALF * BK * 2  , STAGE_BYTES = 8 * HTB, NXCD = 8, WGM = 8;

__host__ __device__ __forceinline__ int lds_byte(int r, int c) { const int st = (r >> 4) * 2 + (c >> 5), rr = r & 15, cc = c & 31, ob = rr * 64 + cc * 2; return st * 1024 + (ob ^ (((ob >> 9) & 1) << 5)); }
__host__ __device__ __forceinline__ void stage_rc(int b, int& R, int& C) { const int st = b / 1024, sb = b % 1024, swz = sb ^ (((sb >> 9) & 1) << 5); R = (st >> 1) * 16 + swz / 64; C = (st & 1) * 32 + (swz % 64) / 2; }
__host__ __device__ __forceinline__ int perm32(int rho) { const int n = rho >> 4, i = rho & 15; return 8 * (i >> 2) + 4 * n + (i & 3); }

struct Unit { int pm, pn; };
struct Gemm { const bf16_t* A; const bf16_t* Bt; int M, N, K; };

struct StaticOrder {
    int nM, nN, nwg, G, c;
    __host__ __device__ void init(int M, int N, int G_, int c_) { nM = M / BM; nN = N / BM; nwg = nM * nN; G = G_; c = c_; }
    __host__ __device__ bool next(int i, Unit& u) const {
        const long L = (long)i * G + c; if (L >= nwg) return false;
        int wgid = (int)L; { const int q = nwg / NXCD, r = nwg % NXCD, xcd = wgid % NXCD, off = wgid / NXCD; wgid = (xcd < r ? xcd * (q + 1) : r * (q + 1) + (xcd - r) * q) + off; }
        const int nig = WGM * nN, gid = wgid / nig, fm = gid * WGM, gsz = (nM - fm) < WGM ? (nM - fm) : WGM;
        u.pm = fm + ((wgid % nig) % gsz); u.pn = (wgid % nig) / gsz; return true;
    }
    __device__ __forceinline__ void a_ready(const Unit&) const {}
    __device__ __forceinline__ void done(const Unit&) const {}
};
__device__ __forceinline__ unsigned cvt_pk_bf16(float lo, float hi) { unsigned r; asm volatile("v_cvt_pk_bf16_f32 %0, %1, %2" : "=v"(r) : "v"(lo), "v"(hi)); return r; }
typedef float f32x2 __attribute__((ext_vector_type(2)));

__device__ __forceinline__ float bf_lo(unsigned w) { return __uint_as_float(w << 16); }
__device__ __forceinline__ float bf_hi(unsigned w) { return __uint_as_float(w & 0xffff0000u); }
__device__ __forceinline__ float sigmoid_f(float x) { return __builtin_amdgcn_rcpf(1.0f + __expf(-x)); }

struct EpiProj {
    static constexpr bool PERM = true, AFTER_DRAIN = false;
    bf16_t *mqk, *mvo, *aq, *akv, *gma;
    __device__ __forceinline__ void operator()(const f32x4 (&acc)[2][2][4][2], const Unit& u, int wr, int wc, int fr, int fq) const {
        const int pn = u.pn; bf16_t* base; int ld, colt;
        if (pn < 8) { base = mqk; ld = 2048; colt = pn * 256; }
        else if (pn < 16) { base = mvo; ld = 2048; colt = (pn - 8) * 256; }
        else if (pn < 20) { base = aq; ld = 1024; colt = (pn - 16) * 256; }
        else if (pn == 20) { base = akv; ld = 256; colt = 0; }
        else { base = gma; ld = 2048; colt = (pn - 21) * 256; }
        const int row0 = u.pm * BM + wr * 64 + fr, col0 = colt + wc * 32 + 8 * fq;
#pragma unroll
        for (int ai = 0; ai < 2; ++ai)
#pragma unroll
            for (int m = 0; m < 4; ++m) { bf16_t* rowp = base + (size_t)(row0 + ai * HALF + m * 16) * ld + col0;
#pragma unroll
                for (int bj = 0; bj < 2; ++bj) { const f32x4 v0 = acc[ai][bj][m][0], v1 = acc[ai][bj][m][1];
                    u32x4 w; w.x = cvt_pk_bf16(v0[0], v0[1]); w.y = cvt_pk_bf16(v0[2], v0[3]); w.z = cvt_pk_bf16(v1[0], v1[1]); w.w = cvt_pk_bf16(v1[2], v1[3]);
                    *(u32x4*)(rowp + bj * HALF) = w; } }
    }
};
template <bool ADD> struct EpiGate {
    static constexpr bool PERM = true, AFTER_DRAIN = false;
    bf16_t* T; const bf16_t* G; const float* bias;
    __device__ __forceinline__ void operator()(const f32x4 (&acc)[2][2][4][2], const Unit& u, int wr, int wc, int fr, int fq) const {
        const int row0 = u.pm * BM + wr * 64 + fr, col0 = u.pn * BM + wc * 32 + 8 * fq;
        f32x4 bv[2][2];
#pragma unroll
        for (int bj = 0; bj < 2; ++bj)
#pragma unroll
            for (int n = 0; n < 2; ++n) bv[bj][n] = *(const f32x4*)(bias + col0 + bj * HALF + 4 * n);
        u32x4 gc[2], tc[2], gn[2], tn[2];
#pragma unroll
        for (int bj = 0; bj < 2; ++bj) { gc[bj] = *(const u32x4*)(G + (size_t)row0 * 2048 + col0 + bj * HALF); if (ADD) tc[bj] = *(const u32x4*)(T + (size_t)row0 * 1024 + col0 + bj * HALF); }
#pragma unroll
        for (int gi = 0; gi < 8; ++gi) { const int ai = gi >> 2, m = gi & 3; const size_t r = (size_t)(row0 + ai * HALF + m * 16);
            if (gi < 7) { const size_t rn = (size_t)(row0 + ((gi + 1) >> 2) * HALF + ((gi + 1) & 3) * 16);
#pragma unroll
                for (int bj = 0; bj < 2; ++bj) { gn[bj] = *(const u32x4*)(G + rn * 2048 + col0 + bj * HALF); if (ADD) tn[bj] = *(const u32x4*)(T + rn * 1024 + col0 + bj * HALF); } }
#pragma unroll
            for (int bj = 0; bj < 2; ++bj) {
                const u32x4 g = gc[bj];
                f32x4 v0 = acc[ai][bj][m][0], v1 = acc[ai][bj][m][1];
                v0[0] *= sigmoid_f(bf_lo(g.x) + bv[bj][0][0]); v0[1] *= sigmoid_f(bf_hi(g.x) + bv[bj][0][1]);
                v0[2] *= sigmoid_f(bf_lo(g.y) + bv[bj][0][2]); v0[3] *= sigmoid_f(bf_hi(g.y) + bv[bj][0][3]);
                v1[0] *= sigmoid_f(bf_lo(g.z) + bv[bj][1][0]); v1[1] *= sigmoid_f(bf_hi(g.z) + bv[bj][1][1]);
                v1[2] *= sigmoid_f(bf_lo(g.w) + bv[bj][1][2]); v1[3] *= sigmoid_f(bf_hi(g.w) + bv[bj][1][3]);
                if (ADD) { const u32x4 t = tc[bj];
                    v0[0] += bf_lo(t.x); v0[1] += bf_hi(t.x); v0[2] += bf_lo(t.y); v0[3] += bf_hi(t.y);
                    v1[0] += bf_lo(t.z); v1[1] += bf_hi(t.z); v1[2] += bf_lo(t.w); v1[3] += bf_hi(t.w); }
                u32x4 w; w.x = cvt_pk_bf16(v0[0], v0[1]); w.y = cvt_pk_bf16(v0[2], v0[3]); w.z = cvt_pk_bf16(v1[0], v1[1]); w.w = cvt_pk_bf16(v1[2], v1[3]);
                *(u32x4*)(T + r * 1024 + col0 + bj * HALF) = w; }
            if (gi < 7) {
#pragma unroll
                for (int bj = 0; bj < 2; ++bj) { gc[bj] = gn[bj]; if (ADD) tc[bj] = tn[bj]; } } }
    }
};
struct PanelOrder {
    int nM, nN, G, c;
    __host__ __device__ void init(int M, int N, int G_, int c_) { nM = M / BM; nN = N / BM; G = G_; c = c_; }
    __host__ __device__ bool next(int i, Unit& u) const { const int pm = c + (i / nN) * G; if (pm >= nM) return false; u.pm = pm; u.pn = i % nN; return true; }
    __device__ __forceinline__ void a_ready(const Unit&) const {}
    __device__ __forceinline__ void done(const Unit&) const {}
};
struct EpiX1 {
    static constexpr bool PERM = false, AFTER_DRAIN = false;
    const float* x; float* x1; bf16_t* x1b; float* ssq; mutable float part[8];
    __device__ __forceinline__ void operator()(const f32x4 (&acc)[2][2][4][2], const Unit& u, int wr, int wc, int fr, int fq) const {
        const int row0 = u.pm * BM + wr * 64 + fr, col0 = u.pn * BM + wc * 32 + 4 * fq;
        if (u.pn == 0) {
#pragma unroll
            for (int gi = 0; gi < 8; ++gi) part[gi] = 0.f; }
        f32x4 xc[4], xn[4];
#pragma unroll
        for (int q = 0; q < 4; ++q) xc[q] = *(const f32x4*)(x + (size_t)row0 * 1024 + col0 + (q >> 1) * HALF + (q & 1) * 16);
#pragma unroll
        for (int gi = 0; gi < 8; ++gi) { const int ai = gi >> 2, m = gi & 3; const size_t r = (size_t)(row0 + ai * HALF + m * 16);
            if (gi < 7) { const size_t rn = (size_t)(row0 + ((gi + 1) >> 2) * HALF + ((gi + 1) & 3) * 16);
#pragma unroll
                for (int q = 0; q < 4; ++q) xn[q] = *(const f32x4*)(x + rn * 1024 + col0 + (q >> 1) * HALF + (q & 1) * 16); }
            float s = 0.f;
#pragma unroll
            for (int q = 0; q < 4; ++q) { const size_t o = r * 1024 + col0 + (q >> 1) * HALF + (q & 1) * 16;
                const f32x4 v = xc[q] + acc[ai][q >> 1][m][q & 1];
                *(f32x4*)(x1 + o) = v; s += (v[0] * v[0] + v[1] * v[1]) + (v[2] * v[2] + v[3] * v[3]);
                uint2 w; w.x = cvt_pk_bf16(v[0], v[1]); w.y = cvt_pk_bf16(v[2], v[3]); *(uint2*)(x1b + o) = w; }
            part[gi] += s;
            if (gi < 7) {
#pragma unroll
                for (int q = 0; q < 4; ++q) xc[q] = xn[q]; } }
        if (u.pn == 3) {
#pragma unroll
            for (int gi = 0; gi < 8; ++gi) { float s = part[gi]; s += __shfl_xor(s, 16); s += __shfl_xor(s, 32);
                if (fq == 0) ssq[(size_t)(row0 + (gi >> 2) * HALF + (gi & 3) * 16) * 4 + wc] = s; } }
    }
};
struct EpiSwiGLU {
    static constexpr bool PERM = true, AFTER_DRAIN = false;
    const float* ssq; bf16_t* act; float eps;
    __device__ __forceinline__ void operator()(const f32x4 (&acc)[2][2][4][2], const Unit& u, int wr, int wc, int fr, int fq) const {
        const int row0 = u.pm * BM + wr * 64 + fr, col0 = u.pn * HALF + wc * 32 + 8 * fq;
        float rs[8];
#pragma unroll
        for (int gi = 0; gi < 8; ++gi) { const f32x4 s = *(const f32x4*)(ssq + (size_t)(row0 + (gi >> 2) * HALF + (gi & 3) * 16) * 4);
            rs[gi] = __builtin_amdgcn_rsqf(((s[0] + s[1]) + (s[2] + s[3])) * (1.0f / 1024.0f) + eps); }
#pragma unroll
        for (int gi = 0; gi < 8; ++gi) { const int ai = gi >> 2, m = gi & 3; const size_t r = (size_t)(row0 + ai * HALF + m * 16); const float rstd = rs[gi];
            float a[8];
#pragma unroll
            for (int n = 0; n < 2; ++n)
#pragma unroll
                for (int j = 0; j < 4; ++j) { const float g = rstd * acc[ai][0][m][n][j], up = rstd * acc[ai][1][m][n][j]; a[4 * n + j] = g * sigmoid_f(g) * up; }
            u32x4 w; w.x = cvt_pk_bf16(a[0], a[1]); w.y = cvt_pk_bf16(a[2], a[3]); w.z = cvt_pk_bf16(a[4], a[5]); w.w = cvt_pk_bf16(a[6], a[7]);
            *(u32x4*)(act + r * 2816 + col0) = w; }
    }
};
struct EpiOut {
    static constexpr bool PERM = false, AFTER_DRAIN = false;
    float* out;
    __device__ __forceinline__ void operator()(const f32x4 (&acc)[2][2][4][2], const Unit& u, int wr, int wc, int fr, int fq) const {
        const int row0 = u.pm * BM + wr * 64 + fr, col0 = u.pn * BM + wc * 32 + 4 * fq;
        f32x4 xc[4], xn[4];
#pragma unroll
        for (int q = 0; q < 4; ++q) xc[q] = *(const f32x4*)(out + (size_t)row0 * 1024 + col0 + (q >> 1) * HALF + (q & 1) * 16);
#pragma unroll
        for (int gi = 0; gi < 8; ++gi) { const int ai = gi >> 2, m = gi & 3; const size_t r = (size_t)(row0 + ai * HALF + m * 16);
            if (gi < 7) { const size_t rn = (size_t)(row0 + ((gi + 1) >> 2) * HALF + ((gi + 1) & 3) * 16);
#pragma unroll
                for (int q = 0; q < 4; ++q) xn[q] = *(const f32x4*)(out + rn * 1024 + col0 + (q >> 1) * HALF + (q & 1) * 16); }
#pragma unroll
            for (int q = 0; q < 4; ++q) *(f32x4*)(out + r * 1024 + col0 + (q >> 1) * HALF + (q & 1) * 16) = xc[q] + acc[ai][q >> 1][m][q & 1];
            if (gi < 7) {
#pragma unroll
                for (int q = 0; q < 4; ++q) xc[q] = xn[q]; } }
    }
};

template <class Epi, class Sched, bool ALIGN_EPI = false, bool SP2 = false>
__device__ __forceinline__ void gemm_phase(PG8_LAS unsigned char* lds, const Gemm g, const Sched& S, const Epi& E) {
    const int tid = threadIdx.x, wid = __builtin_amdgcn_readfirstlane(tid >> 6), lane = tid & 63, wr = wid >> 2, wc = wid & 3, fr = lane & 15, fq = lane >> 4;
    const int K = g.K, nt = K / BK;
    unsigned voffA[2], voffB[2];
#pragma unroll
    for (int i = 0; i < 2; ++i) { int R, C; stage_rc(tid * 16 + i * 8192, R, C); const int Rb = Epi::PERM ? ((R & ~31) + perm32(R & 31)) : R;
        voffA[i] = (unsigned)(R * K + C) * 2u; voffB[i] = (unsigned)(Rb * K + C) * 2u; }
    const size_t kstep = (size_t)(BK * 2);
    const size_t hstep = (size_t)HALF * K * 2;
    const size_t tstep = 2 * hstep;
    const unsigned ldsw = (unsigned)wid * 1024u;
    const int aoff = lds_byte(wr * 64 + fr, fq * 8), boff = lds_byte(wc * 32 + fr, fq * 8);
#define PG8_SA(b, h) (((b) * 2 + (h)) * HTB)
#define PG8_SB(b, h) ((4 + (b) * 2 + (h)) * HTB)
#define PG8_STAGE(bufoff, gbase, voff) do { _Pragma("unroll") for (int _i = 0; _i < 2; ++_i) \
        __builtin_amdgcn_global_load_lds((const unsigned*)((const char*)(gbase) + (voff)[_i]), (PG8_LAS unsigned*)(lds + (bufoff) + ldsw + _i * 8192), 16, 0, 0); } while (0)
#define PG8_LDA(dst, b, h) do { _Pragma("unroll") for (int m = 0; m < 4; ++m) _Pragma("unroll") for (int k = 0; k < 2; ++k) dst[m][k] = *(const PG8_LAS bf16x8*)(lds + PG8_SA(b, h) + aoff + m * 2048 + k * 1024); } while (0)
#define PG8_LDB(dst, b, h) do { _Pragma("unroll") for (int n = 0; n < 2; ++n) _Pragma("unroll") for (int k = 0; k < 2; ++k) dst[n][k] = *(const PG8_LAS bf16x8*)(lds + PG8_SB(b, h) + boff + n * 2048 + k * 1024); } while (0)
#define PG8_MMA(ai, bj, At, Bt) do { __builtin_amdgcn_s_setprio(1); _Pragma("unroll") for (int m = 0; m < 4; ++m) _Pragma("unroll") for (int n = 0; n < 2; ++n) _Pragma("unroll") for (int k = 0; k < 2; ++k) \
        acc[ai][bj][m][n] = __builtin_amdgcn_mfma_f32_16x16x32_bf16(Bt[n][k], At[m][k], acc[ai][bj][m][n], 0, 0, 0); __builtin_amdgcn_s_setprio(0); } while (0)
#define PG8_WAIT_V(n) asm volatile("s_waitcnt vmcnt(" #n ")" ::: "memory")
#define PG8_WAIT_L(n) asm volatile("s_waitcnt lgkmcnt(" #n ")" ::: "memory")
#define PG8_BAR __builtin_amdgcn_s_barrier()
#define PG8_SCHED __builtin_amdgcn_sched_barrier(0)
    Unit cur, nxt; int ui = 0;
    if (!S.next(0, cur)) return;
    f32x4 acc[2][2][4][2];
#pragma unroll
    for (int a = 0; a < 2; ++a)
#pragma unroll
        for (int b = 0; b < 2; ++b)
#pragma unroll
            for (int m = 0; m < 4; ++m)
#pragma unroll
                for (int n = 0; n < 2; ++n) acc[a][b][m][n] = (f32x4){0.f, 0.f, 0.f, 0.f};
    bf16x8 At[4][2], B0[2][2], B1[2][2];
    const char* cA = (const char*)g.A + (size_t)cur.pm * tstep; const char* cB = (const char*)g.Bt + (size_t)cur.pn * tstep;
    S.a_ready(cur);
    if constexpr (SP2) {
        PG8_STAGE(PG8_SB(0, 0), cB, voffB); PG8_STAGE(PG8_SB(0, 1), cB + hstep, voffB); PG8_STAGE(PG8_SA(0, 0), cA, voffA); PG8_STAGE(PG8_SA(0, 1), cA + hstep, voffA);
        if (wr == 1) PG8_BAR;
        PG8_WAIT_V(2); PG8_BAR;
        PG8_STAGE(PG8_SB(1, 0), cB + kstep, voffB); PG8_STAGE(PG8_SA(1, 0), cA + kstep, voffA); PG8_STAGE(PG8_SB(1, 1), cB + hstep + kstep, voffB);
        PG8_WAIT_V(6); PG8_BAR;
    } else {
        PG8_STAGE(PG8_SB(0, 0), cB, voffB); PG8_STAGE(PG8_SA(0, 0), cA, voffA); PG8_STAGE(PG8_SB(0, 1), cB + hstep, voffB); PG8_STAGE(PG8_SA(0, 1), cA + hstep, voffA);
        if (wr == 1) PG8_BAR;
        PG8_WAIT_V(4); PG8_BAR;
        PG8_STAGE(PG8_SB(1, 0), cB + kstep, voffB); PG8_STAGE(PG8_SA(1, 0), cA + kstep, voffA); PG8_STAGE(PG8_SB(1, 1), cB + hstep + kstep, voffB);
        PG8_WAIT_V(6); PG8_BAR;
    }
    for (;;) {
        const bool has_next = S.next(ui + 1, nxt);
        const char* nA = has_next ? (const char*)g.A + (size_t)nxt.pm * tstep : cA; const char* nB = has_next ? (const char*)g.Bt + (size_t)nxt.pn * tstep : cB;
        for (int t = 0; t < nt; t += 2) {
            const bool last = (t == nt - 2);
            const char* a1 = cA + (size_t)(t + 1) * kstep;
            const char* a2 = last ? nA : cA + (size_t)(t + 2) * kstep; const char* b2 = last ? nB : cB + (size_t)(t + 2) * kstep;
            const char* a3 = a2 + kstep; const char* b3 = b2 + kstep;
            if (last && has_next) S.a_ready(nxt);
            if constexpr (SP2) {
            PG8_LDB(B0, 0, 0); PG8_LDB(B1, 0, 1); PG8_SCHED; PG8_LDA(At, 0, 0); PG8_STAGE(PG8_SA(1, 1), a1 + hstep, voffA);
            PG8_WAIT_V(8); PG8_WAIT_L(0); PG8_BAR; PG8_MMA(0, 0, At, B0); PG8_MMA(0, 1, At, B1); PG8_BAR; PG8_SCHED;
            PG8_LDA(At, 0, 1); PG8_STAGE(PG8_SB(0, 0), b2, voffB); PG8_STAGE(PG8_SB(0, 1), b2 + hstep, voffB); PG8_STAGE(PG8_SA(0, 0), a2, voffA);
            PG8_WAIT_V(8); PG8_WAIT_L(0); PG8_BAR; PG8_MMA(1, 0, At, B0); PG8_MMA(1, 1, At, B1); PG8_BAR; PG8_SCHED;
            PG8_LDB(B0, 1, 0); PG8_LDB(B1, 1, 1); PG8_SCHED; PG8_LDA(At, 1, 0); PG8_STAGE(PG8_SA(0, 1), a2 + hstep, voffA);
            PG8_WAIT_V(8); PG8_WAIT_L(0); PG8_BAR; PG8_MMA(0, 0, At, B0); PG8_MMA(0, 1, At, B1); PG8_BAR; PG8_SCHED;
            PG8_LDA(At, 1, 1); PG8_STAGE(PG8_SB(1, 0), b3, voffB); PG8_STAGE(PG8_SB(1, 1), b3 + hstep, voffB); PG8_STAGE(PG8_SA(1, 0), a3, voffA);
            PG8_WAIT_V(8); PG8_WAIT_L(0); PG8_BAR; PG8_MMA(1, 0, At, B0); PG8_MMA(1, 1, At, B1); PG8_BAR; PG8_SCHED;
            } else {
            PG8_LDB(B0, 0, 0); PG8_SCHED; PG8_LDA(At, 0, 0); PG8_STAGE(PG8_SA(1, 1), a1 + hstep, voffA);
            PG8_WAIT_L(8); PG8_BAR; PG8_WAIT_L(0); PG8_MMA(0, 0, At, B0); PG8_BAR; PG8_SCHED;
            PG8_LDB(B1, 0, 1); PG8_STAGE(PG8_SB(0, 0), b2, voffB);
            PG8_BAR; PG8_WAIT_L(0); PG8_MMA(0, 1, At, B1); PG8_BAR;
            PG8_LDA(At, 0, 1); PG8_STAGE(PG8_SA(0, 0), a2, voffA);
            PG8_BAR; PG8_WAIT_L(0); PG8_MMA(1, 0, At, B0); PG8_BAR; PG8_SCHED;
            PG8_STAGE(PG8_SB(0, 1), b2 + hstep, voffB);
            PG8_WAIT_V(6); PG8_BAR; PG8_MMA(1, 1, At, B1); PG8_BAR;
            PG8_LDB(B0, 1, 0); PG8_SCHED; PG8_LDA(At, 1, 0); PG8_STAGE(PG8_SA(0, 1), a2 + hstep, voffA);
            PG8_WAIT_L(8); PG8_BAR; PG8_WAIT_L(0); PG8_MMA(0, 0, At, B0); PG8_BAR; PG8_SCHED;
            PG8_LDB(B1, 1, 1); PG8_STAGE(PG8_SB(1, 0), b3, voffB);
            PG8_BAR; PG8_WAIT_L(0); PG8_MMA(0, 1, At, B1); PG8_BAR;
            PG8_LDA(At, 1, 1); PG8_STAGE(PG8_SA(1, 0), a3, voffA);
            PG8_BAR; PG8_WAIT_L(0); PG8_MMA(1, 0, At, B0); PG8_BAR; PG8_SCHED;
            PG8_STAGE(PG8_SB(1, 1), b3 + hstep, voffB);
            PG8_WAIT_V(6); PG8_BAR; PG8_MMA(1, 1, At, B1); PG8_BAR;
            }
        }
        if constexpr (ALIGN_EPI) { if (wr == 0) PG8_BAR; }
        if constexpr (!Epi::AFTER_DRAIN) { E(acc, cur, wr, wc, fr, fq); S.done(cur); }
        if (!has_next) break;
#pragma unroll
        for (int a = 0; a < 2; ++a)
#pragma unroll
            for (int b = 0; b < 2; ++b)
#pragma unroll
                for (int m = 0; m < 4; ++m)
#pragma unroll
                    for (int n = 0; n < 2; ++n) acc[a][b][m][n] = (f32x4){0.f, 0.f, 0.f, 0.f};
        cur = nxt; cA = nA; cB = nB; ++ui;
        if constexpr (ALIGN_EPI) { if (wr == 1) PG8_BAR; }
    }
    PG8_WAIT_V(0);
    if constexpr (!ALIGN_EPI) { if (wr == 0) PG8_BAR; }
    PG8_BAR;
    if constexpr (Epi::AFTER_DRAIN) { E.fused(acc, cur, wr, wc, fr, fq, lds, wid, lane); S.done(cur); }
#undef PG8_SA
#undef PG8_SB
#undef PG8_STAGE
#undef PG8_LDA
#undef PG8_LDB
#undef PG8_MMA
#undef PG8_WAIT_V
#undef PG8_WAIT_L
#undef PG8_BAR
#undef PG8_SCHED
}
}
#ifndef PG8_SP2
#define PG8_SP2 true
#endif
#ifndef PG8_ALIGN
#define PG8_ALIGN true
#endif
#define GAS __attribute__((address_space(1)))
#define LAS __attribute__((address_space(3)))
typedef unsigned short bf16;
typedef unsigned v4u __attribute__((ext_vector_type(4)));
typedef float f32x4 __attribute__((ext_vector_type(4)));
typedef short bf16x8 __attribute__((ext_vector_type(8)));
typedef GAS unsigned gu32;
typedef GAS unsigned long long gu64;
#define RLX_AGENT __ATOMIC_RELAXED, __HIP_MEMORY_SCOPE_AGENT
#define LDS_WAIT() asm volatile("s_waitcnt lgkmcnt(0)" ::: "memory")
#define VM_WAIT() asm volatile("s_waitcnt vmcnt(0)" ::: "memory")
__device__ __forceinline__ unsigned long long rt() { return __builtin_amdgcn_s_memrealtime(); }
__device__ __forceinline__ unsigned f2bf(float f) { unsigned u = __builtin_bit_cast(unsigned, f); return (u + 0x7fffu + ((u >> 16) & 1u)) >> 16; }
__device__ __forceinline__ unsigned pk2(float lo, float hi) { return f2bf(lo) | (f2bf(hi) << 16); }
#define XB_TMO      128
#define XB_XCNT(j)  (256  + 64 * (j))
#define XB_XSUB(j)  (1280 + 64 * (j))
#define XB_XGEN(j)  (2304 + 64 * (j))
#define XB_TOP      3328
#define XB_TOPGEN   3392
#define XCD_BAR_WORDS 3456
#define XB_SPIN_CAP (1u << 18)

__device__ __forceinline__ unsigned xb_ld(unsigned* p)              { return __hip_atomic_load(p, __ATOMIC_RELAXED, __HIP_MEMORY_SCOPE_AGENT); }
__device__ __forceinline__ unsigned xb_add(unsigned* p, unsigned v) { return __hip_atomic_fetch_add(p, v, __ATOMIC_RELAXED, __HIP_MEMORY_SCOPE_AGENT); }
__device__ __forceinline__ unsigned xb_xcc_id() { return (unsigned)__builtin_amdgcn_s_getreg((3 << 11) | 20) & 0xFu; }
#define XB_SPIN(cond, bar) do { unsigned _sp = 0; while (cond) { __builtin_amdgcn_s_sleep(1); \
    if ((++_sp & 255u) == 0u) { if (xb_ld(&(bar)[XB_TMO])) break; if (_sp > XB_SPIN_CAP) { atomicAdd(&(bar)[XB_TMO], 1u); break; } } } } while (0)

struct XcdBarrier {
    unsigned* bar; unsigned x;
    volatile LAS unsigned* st;
};

__device__ __forceinline__ XcdBarrier xcd_barrier_post(unsigned* bar, volatile LAS unsigned* st) {
    XcdBarrier b; b.bar = bar; b.x = xb_xcc_id(); b.st = st;
    if (threadIdx.x == 0) (void)xb_add(&bar[XB_XCNT(b.x)], 1u);
    return b;
}
__device__ __forceinline__ void xcd_barrier_complete(unsigned* bar, unsigned x, unsigned& nloc, unsigned& nx) {
    const unsigned G = gridDim.x * gridDim.y * gridDim.z;
    unsigned sum, cnt, mine, sp = 0u;
    for (;;) {
        sum = 0u; cnt = 0u; mine = 0u;
#pragma unroll
        for (unsigned j = 0; j < 16; ++j) { const unsigned c = xb_ld(&bar[XB_XCNT(j)]); sum += c; cnt += (c > 0u) ? 1u : 0u; mine = (j == x) ? c : mine; }
        if (sum == G) break;
        __builtin_amdgcn_s_sleep(1);
        if ((++sp & 255u) == 0u) { if (xb_ld(&bar[XB_TMO])) break; if (sp > XB_SPIN_CAP) { atomicAdd(&bar[XB_TMO], 1u); break; } }
    }
    nloc = mine > 0u ? mine : 1u; nx = cnt > 0u ? cnt : 1u;
}

__device__ __forceinline__ void xcd_barrier(const XcdBarrier& b) {
    asm volatile("s_waitcnt vmcnt(0)" ::: "memory");
    __syncthreads();
    if (threadIdx.x == 0) {
        unsigned* bar = b.bar;
        __builtin_amdgcn_s_waitcnt(0);
        unsigned nloc = b.st[0], nx = b.st[1];
        if (nloc == 0u) { xcd_barrier_complete(bar, b.x, nloc, nx); b.st[0] = nloc; b.st[1] = nx; }
        const unsigned old = xb_add(&bar[XB_XSUB(b.x)], 1u);
        const unsigned gen = old / nloc;
        if (old + 1u == (gen + 1u) * nloc) {
            __builtin_amdgcn_fence(__ATOMIC_RELEASE, "agent");
            asm volatile("s_waitcnt vmcnt(0)" ::: "memory");
            const unsigned og = xb_add(&bar[XB_TOP], 1u);
            const unsigned tg = og / nx;
            if (og + 1u == (tg + 1u) * nx) xb_add(&bar[XB_TOPGEN], 1u);
            else XB_SPIN(xb_ld(&bar[XB_TOPGEN]) == tg, bar);
            __builtin_amdgcn_fence(__ATOMIC_ACQUIRE, "agent");
            xb_add(&bar[XB_XGEN(b.x)], 1u);
            asm volatile("s_waitcnt vmcnt(0)" ::: "memory");
        } else {
            XB_SPIN(xb_ld(&bar[XB_XGEN(b.x)]) == gen, bar);
            __builtin_amdgcn_fence(__ATOMIC_ACQUIRE, "agent");
            asm volatile("s_waitcnt vmcnt(0)" ::: "memory");
        }
    }
    __syncthreads();
}

constexpr int NB = 16, SEQ = 4096, D = 1024, M = NB * SEQ;
constexpr int NIN = 7432, NPROJ = 7424, DFF = 2816, NFF2 = 5632;
constexpr float EPS = 1e-6f;
constexpr int NWAVES = 8;
constexpr size_t MiB = 1u << 20;
constexpr size_t WS_CTL = 0, CTL_ZERO_BYTES = 1 * MiB;
constexpr size_t WS_W1T = 2 * MiB, WS_WBM = 17 * MiB, WS_WBA = 19 * MiB, WS_WOUT = 21 * MiB, WS_WFI = 23 * MiB, WS_WFO = 34 * MiB;
constexpr size_t WS_GATES = 40 * MiB;
constexpr size_t WS_ROPE = 42 * MiB;
constexpr size_t WS_SSQ2 = 43 * MiB;
constexpr size_t WS_MQK = 48 * MiB, WS_MVO = 304 * MiB, WS_AQ = 560 * MiB, WS_AKV = 688 * MiB, WS_GMA = 720 * MiB;
constexpr size_t WS_T = WS_MQK;
constexpr size_t WS_X1B = WS_MVO;
constexpr size_t WS_ACT = WS_AQ;
constexpr size_t WS_KN = 976 * MiB;
constexpr size_t WS_END = 1024 * MiB;
static_assert(WS_W1T + (size_t)NPROJ * D * 2 <= WS_WBM && WS_WFI + (size_t)NFF2 * D * 2 <= WS_WFO && WS_WFO + (size_t)D * DFF * 2 <= WS_GATES, "weights map");
static_assert(WS_ACT + (size_t)M * DFF * 2 <= WS_KN && WS_GMA + (size_t)M * 2048 * 2 <= WS_KN, "ws map");
constexpr int CW_BAR = 4096;
constexpr size_t DO_YA = 128 * MiB;
constexpr int RING_OFF = 0, RING_BYTES = 131072, LDSCTL_OFF = RING_BYTES, MISC_OFF = LDSCTL_OFF + 320, LDS_BYTES = 147456;

typedef GAS float gf32;

__device__ __forceinline__ float wave_sum(float v) {
#pragma unroll
    for (int o = 1; o < 64; o <<= 1) v += __shfl_xor(v, o);
    return v;
}
__device__ __forceinline__ float bf2f(bf16 b) { return __uint_as_float(((unsigned)b) << 16); }

struct Frame {
    LAS unsigned char* lds;
    volatile LAS unsigned* MISC;
    gu32* ctl;
    int tid, lane, wave, vcu, G;
};

__device__ __forceinline__ void p0_transpose_item(const float* W, int ldw, int csrc, int K, bf16* WT, int ndst, int k0, const float* rowscale, LAS float* scr, int lane) {
#pragma unroll 8
    for (int i = 0; i < 32; ++i) { const int kk = 2 * i + (lane >> 5); float v = W[(size_t)(k0 + kk) * ldw + csrc + (lane & 31)]; if (rowscale) v *= rowscale[k0 + kk]; scr[kk * 33 + (lane & 31)] = v; }
    LDS_WAIT(); asm volatile("" ::: "memory");
    const int c = lane & 7;
#pragma unroll
    for (int j = 0; j < 4; ++j) { const int n = (lane >> 3) + 8 * j; const LAS float* s = scr + (8 * c) * 33 + n;
        v4u o; o.x = pk2(s[0 * 33], s[1 * 33]); o.y = pk2(s[2 * 33], s[3 * 33]); o.z = pk2(s[4 * 33], s[5 * 33]); o.w = pk2(s[6 * 33], s[7 * 33]);
        *(GAS v4u*)(WT + (size_t)(ndst + n) * K + k0 + 8 * c) = o; }
    LDS_WAIT(); asm volatile("" ::: "memory");
}

struct Args { const float* in[17]; float* out; unsigned char* ws; int ph_lo, ph_hi; };

__device__ __forceinline__ void p0_prologue(Frame& F, const Args& A) {
    unsigned char* ws = A.ws;
    LAS float* scr = (LAS float*)(F.lds + RING_OFF + F.wave * 16384);
    const int gw = F.vcu * NWAVES + F.wave, NGW = F.G * NWAVES;
    constexpr int I_IN = 16 * (NPROJ / 32), I_SQ = 16 * 32, I_FI = 16 * (NFF2 / 32), I_FO = (DFF / 64) * 32;
    constexpr int NITEMS = I_IN + 3 * I_SQ + I_FI + I_FO;
    for (int it = gw; it < NITEMS; it += NGW) {
        int r = it;
        if (r < I_IN) { const int nb = r % (NPROJ / 32), kb = r / (NPROJ / 32), n0 = 32 * nb; p0_transpose_item(A.in[2], NIN, n0 + (n0 >= 4096 ? 8 : 0), D, (bf16*)(ws + WS_W1T), n0, 64 * kb, nullptr, scr, F.lane); continue; } r -= I_IN;
        if (r < I_SQ) { p0_transpose_item(A.in[11], D, 32 * (r % 32), D, (bf16*)(ws + WS_WBM), 32 * (r % 32), 64 * (r / 32), A.in[6], scr, F.lane); continue; } r -= I_SQ;
        if (r < I_SQ) { p0_transpose_item(A.in[12], D, 32 * (r % 32), D, (bf16*)(ws + WS_WBA), 32 * (r % 32), 64 * (r / 32), nullptr, scr, F.lane); continue; } r -= I_SQ;
        if (r < I_SQ) { p0_transpose_item(A.in[13], D, 32 * (r % 32), D, (bf16*)(ws + WS_WOUT), 32 * (r % 32), 64 * (r / 32), nullptr, scr, F.lane); continue; } r -= I_SQ;
        if (r < I_FI) { const int nb = r % (NFF2 / 32), kb = r / (NFF2 / 32), n0 = 32 * nb, tile = n0 >> 8, c = n0 & 255;
            const int csrc = (c < 128) ? 128 * tile + c : DFF + 128 * tile + (c - 128);
            p0_transpose_item(A.in[15], NFF2, csrc, D, (bf16*)(ws + WS_WFI), n0, 64 * kb, A.in[14], scr, F.lane); continue; } r -= I_FI;
        p0_transpose_item(A.in[16], D, 32 * (r % 32), DFF, (bf16*)(ws + WS_WFO), 32 * (r % 32), 64 * (r / 32), nullptr, scr, F.lane);
    }
    { const int idx = blockIdx.x * (NWAVES * 64) + F.tid;
      if (idx < SEQ * 8) { const int pos = idx >> 3, i = idx & 7;
        const double invf[8] = {1.0, 0.19392274474868576, 0.03760603093086393, 0.007292664737217109, 0.001414213562373095, 0.0002742481756762073, 5.318295896944988e-05, 1.031338537721246e-05};
        double f = invf[0];
#pragma unroll
        for (int q = 1; q < 8; ++q) f = (i == q) ? invf[q] : f;
        double t = (double)pos * f * 0.15915494309189535; t -= __builtin_rint(t);
        float2 cs; cs.x = __builtin_amdgcn_cosf((float)t); cs.y = __builtin_amdgcn_sinf((float)t);
        ((float2*)(ws + WS_ROPE))[idx] = cs; } }
    __syncthreads();
    LAS float* gwa = (LAS float*)(F.lds + RING_OFF); LAS float* gwb = gwa + 4096;
    for (int idx = F.tid; idx < 1024 * 8; idx += NWAVES * 64) { const int k = idx >> 3, c = idx & 7; const float v = A.in[2][(size_t)k * NIN + 4096 + c];
        const int j = k >> 8, ln = (k >> 2) & 63, i = k & 3; LAS float* dst = (c < 4) ? gwa : gwb; dst[((j * 4 + i) * 64 + ln) * 4 + (c & 3)] = v; }
    __syncthreads();
    const float* x = A.in[0]; const float* g1 = A.in[1]; const float* bg = A.in[5];
    bf16* H1 = (bf16*)A.out; float* gates = (float*)(ws + WS_GATES);
    f32x4 gv[4];
#pragma unroll
    for (int j = 0; j < 4; ++j) gv[j] = ((const GAS f32x4*)g1)[F.lane + 64 * j];
    for (int m = gw; m < M; m += NGW) {
        const GAS f32x4* xr = (const GAS f32x4*)(x + (size_t)m * D) + F.lane;
        f32x4 v[4]; float s = 0.f;
#pragma unroll
        for (int j = 0; j < 4; ++j) { v[j] = xr[64 * j]; s += (v[j].x * v[j].x + v[j].y * v[j].y) + (v[j].z * v[j].z + v[j].w * v[j].w); }
        const float rstd = 1.0f / sqrtf(wave_sum(s) * (1.0f / D) + EPS);
        GAS unsigned long long* o8 = (GAS unsigned long long*)(H1 + (size_t)m * D) + F.lane;
        float ga[8];
#pragma unroll
        for (int c = 0; c < 8; ++c) ga[c] = 0.f;
#pragma unroll
        for (int j = 0; j < 4; ++j) { v[j] = v[j] * rstd * gv[j];
            o8[64 * j] = (unsigned long long)pk2(v[j].x, v[j].y) | ((unsigned long long)pk2(v[j].z, v[j].w) << 32);
#pragma unroll
            for (int i = 0; i < 4; ++i) { const f32x4 wa = *(const LAS f32x4*)(gwa + ((j * 4 + i) * 64 + F.lane) * 4), wb = *(const LAS f32x4*)(gwb + ((j * 4 + i) * 64 + F.lane) * 4);
                const float hv = v[j][i];
                ga[0] += hv * wa[0]; ga[1] += hv * wa[1]; ga[2] += hv * wa[2]; ga[3] += hv * wa[3];
                ga[4] += hv * wb[0]; ga[5] += hv * wb[1]; ga[6] += hv * wb[2]; ga[7] += hv * wb[3]; } }
#pragma unroll
        for (int c = 0; c < 8; ++c) ga[c] = wave_sum(ga[c]);
        if (F.lane < 8) { float val = ga[0];
#pragma unroll
            for (int c = 1; c < 8; ++c) val = (F.lane == c) ? ga[c] : val;
            val += bg[F.lane];
            if (F.lane >= 4) val = fminf(val, 0.f) - log1pf(__expf(-fabsf(val)));
            gates[(size_t)m * 8 + F.lane] = val; }
    }
}

__device__ __forceinline__ void p3_ymnorm(Frame& F, bf16* HM) {
    const int gw = F.vcu * NWAVES + F.wave, NGW = F.G * NWAVES;
    for (int m = gw; m < M; m += NGW) {
        GAS v4u* p = (GAS v4u*)(HM + (size_t)m * D) + F.lane;
#pragma unroll
        for (int j = 0; j < 2; ++j) { const v4u w = p[64 * j]; float f[8];
            f[0] = __uint_as_float(w.x << 16); f[1] = __uint_as_float(w.x & 0xffff0000u); f[2] = __uint_as_float(w.y << 16); f[3] = __uint_as_float(w.y & 0xffff0000u);
            f[4] = __uint_as_float(w.z << 16); f[5] = __uint_as_float(w.z & 0xffff0000u); f[6] = __uint_as_float(w.w << 16); f[7] = __uint_as_float(w.w & 0xffff0000u);
            float s = 0.f;
#pragma unroll
            for (int i = 0; i < 8; ++i) s += f[i] * f[i];
#pragma unroll
            for (int o = 1; o < 32; o <<= 1) s += __shfl_xor(s, o);
            const float rstd = 1.0f / sqrtf(s * (1.0f / 256.0f) + EPS);
            v4u o; o.x = pk2(f[0] * rstd, f[1] * rstd); o.y = pk2(f[2] * rstd, f[3] * rstd); o.z = pk2(f[4] * rstd, f[5] * rstd); o.w = pk2(f[6] * rstd, f[7] * rstd);
            p[64 * j] = o; }
    }
}

__device__ __forceinline__ float silu_f(float x) { return x / (1.0f + __expf(-x)); }
__global__ void __launch_bounds__(256) k_mlstm_naive(const bf16* MQK, const bf16* MVO, const float* gates, const float* conv_w, const float* conv_b, bf16* HM) {
    const int es = blockIdx.x & 3, bh = blockIdx.x >> 2, h = bh & 3, b = bh >> 2;
    const int tid = threadIdx.x, e = tid & 63, dq = tid >> 6, lane = tid & 63;
    __shared__ float qs[256], ks[256], red[4][64], dred[2][4];
    float C[64];
#pragma unroll
    for (int i = 0; i < 64; ++i) C[i] = 0.f;
    float n = 0.f;
    const int cq = h * 256 + tid, ck = 1024 + h * 256 + tid;
    float wq[4], wk[4];
#pragma unroll
    for (int j = 0; j < 4; ++j) { wq[j] = conv_w[j * 2048 + cq]; wk[j] = conv_w[j * 2048 + ck]; }
    const float bq = conv_b[cq], bk = conv_b[ck];
    float xq0 = 0.f, xq1 = 0.f, xq2 = 0.f, xk0 = 0.f, xk1 = 0.f, xk2 = 0.f;
    for (int t = 0; t < SEQ; ++t) {
        const size_t row = (size_t)b * SEQ + t;
        const float q0 = bf2f(MQK[row * 2048 + cq]), k0 = bf2f(MQK[row * 2048 + ck]);
        const float yq = bq + wq[0] * xq0 + wq[1] * xq1 + wq[2] * xq2 + wq[3] * q0;
        const float yk = bk + wk[0] * xk0 + wk[1] * xk1 + wk[2] * xk2 + wk[3] * k0;
        xq0 = xq1; xq1 = xq2; xq2 = q0; xk0 = xk1; xk1 = xk2; xk2 = k0;
        const float q = silu_f(yq), k = silu_f(yk) * 0.0625f;
        const float ei = __expf(gates[row * 8 + h]), f = __expf(gates[row * 8 + 4 + h]);
        qs[tid] = q; ks[tid] = k;
        n = f * n + ei * k;
        const float dp = wave_sum(n * q);
        if (lane == 0) dred[t & 1][tid >> 6] = dp;
        __syncthreads();
        const float v = bf2f(MVO[row * 2048 + h * 256 + es * 64 + e]);
        float acc = 0.f;
#pragma unroll
        for (int i = 0; i < 64; ++i) { const int d = dq * 64 + i; C[i] = f * C[i] + (ei * ks[d]) * v; acc += C[i] * qs[d]; }
        red[dq][e] = acc;
        __syncthreads();
        if (dq == 0) {
            const float num = (red[0][e] + red[1][e]) + (red[2][e] + red[3][e]);
            const float den = (dred[t & 1][0] + dred[t & 1][1]) + (dred[t & 1][2] + dred[t & 1][3]);
            const float hv = num / fmaxf(fabsf(den), 1.0f);
            const float o = bf2f(MVO[row * 2048 + 1024 + h * 256 + es * 64 + e]);
            HM[row * 1024 + h * 256 + es * 64 + e] = (bf16)f2bf(hv / (1.0f + __expf(-o)));
        }
    }
}
__global__ void __launch_bounds__(256) k_knorm_naive(const bf16* AKV, const float* kg, const float2* rope, float* KN) {
    const int gid = blockIdx.x * 256 + threadIdx.x; if (gid >= M * 2) return;
    const int kvh = gid & 1, row = gid >> 1, t = row & (SEQ - 1);
    float y[64]; float s = 0.f;
#pragma unroll
    for (int d = 0; d < 64; ++d) { y[d] = bf2f(AKV[(size_t)row * 256 + kvh * 64 + d]); s += y[d] * y[d]; }
    const float rstd = 1.0f / sqrtf(s * (1.0f / 64.0f) + EPS);
#pragma unroll
    for (int d = 0; d < 64; ++d) y[d] = y[d] * rstd * kg[d];
#pragma unroll
    for (int i = 0; i < 8; ++i) { const float2 cs = rope[t * 8 + i]; const float x1 = y[i], x2 = y[8 + i]; y[i] = x1 * cs.x - x2 * cs.y; y[8 + i] = x2 * cs.x + x1 * cs.y; }
#pragma unroll
    for (int d = 0; d < 64; ++d) KN[(size_t)row * 128 + kvh * 64 + d] = y[d];
}
__global__ void __launch_bounds__(256) k_attn_naive(const bf16* AQ, const bf16* AKV, const float* KN, const float* qg, const float* sinks, const float2* rope, bf16* YA) {
    const int gid = blockIdx.x * 256 + threadIdx.x;
    const int hq = gid & 15, row = gid >> 4, t = row & (SEQ - 1), kvh = hq >> 3;
    float q[64], o[64]; float s = 0.f;
#pragma unroll
    for (int d = 0; d < 64; ++d) { q[d] = bf2f(AQ[(size_t)row * 1024 + hq * 64 + d]); s += q[d] * q[d]; o[d] = 0.f; }
    const float rstd = 1.0f / sqrtf(s * (1.0f / 64.0f) + EPS);
#pragma unroll
    for (int d = 0; d < 64; ++d) q[d] = q[d] * rstd * qg[d];
#pragma unroll
    for (int i = 0; i < 8; ++i) { const float2 cs = rope[t * 8 + i]; const float x1 = q[i], x2 = q[8 + i]; q[i] = x1 * cs.x - x2 * cs.y; q[8 + i] = x2 * cs.x + x1 * cs.y; }
    float mx = sinks[hq], l = 1.0f;
    const int lo = t - 127 < 0 ? 0 : t - 127;
    for (int sp = lo; sp <= t; ++sp) {
        const size_t kr = (size_t)(row - t + sp);
        const float* kp = KN + kr * 128 + kvh * 64; float dot = 0.f;
#pragma unroll
        for (int d = 0; d < 64; ++d) dot += q[d] * kp[d];
        dot *= 0.125f;
        const float mn = fmaxf(mx, dot), sc = __expf(mx - mn), p = __expf(dot - mn);
        l = l * sc + p; mx = mn;
        const bf16* vp = AKV + kr * 256 + 128 + kvh * 64;
#pragma unroll
        for (int d = 0; d < 64; ++d) o[d] = o[d] * sc + p * bf2f(vp[d]);
    }
    const float il = 1.0f / l;
#pragma unroll
    for (int d = 0; d < 64; ++d) YA[(size_t)row * 1024 + hq * 64 + d] = (bf16)f2bf(o[d] * il);
}

__global__ void __launch_bounds__(NWAVES * 64, 2) fwd(Args args) {
    __shared__ __attribute__((aligned(16))) unsigned char lds[LDS_BYTES];
    Frame F;
    F.lds = (LAS unsigned char*)lds;
    F.MISC = (volatile LAS unsigned*)(F.lds + MISC_OFF);
    F.tid = threadIdx.x; F.lane = F.tid & 63; F.wave = __builtin_amdgcn_readfirstlane(F.tid >> 6);
    F.G = gridDim.x; { const int bx = blockIdx.x; F.vcu = (F.G % 8 == 0) ? (bx % 8) * (F.G / 8) + bx / 8 : bx; }
    unsigned char* ws = args.ws;
    F.ctl = (gu32*)(ws + WS_CTL);
    for (int u = F.tid; u < (LDS_BYTES - LDSCTL_OFF) / 4; u += NWAVES * 64) ((LAS unsigned*)(F.lds + LDSCTL_OFF))[u] = 0u;
    __syncthreads();
    const int lo = args.ph_lo, hi = args.ph_hi;
    XcdBarrier bar; bar.bar = (unsigned*)(F.ctl + CW_BAR); bar.x = 0; bar.st = nullptr;
    if (hi - lo > 1) bar = xcd_barrier_post((unsigned*)(F.ctl + CW_BAR), F.MISC + 8);
#define IN(k) (lo <= (k) && (k) < hi)
#define BOTH(k) (IN(k) && IN((k) + 1))
#define GRID_BAR() xcd_barrier(bar)
    bf16* H1 = (bf16*)args.out; bf16* YM = (bf16*)args.out; bf16* YA = (bf16*)((unsigned char*)args.out + DO_YA);
    bf16* MQK = (bf16*)(ws + WS_MQK); bf16* MVO = (bf16*)(ws + WS_MVO); bf16* AQ = (bf16*)(ws + WS_AQ); bf16* AKV = (bf16*)(ws + WS_AKV); bf16* GMA = (bf16*)(ws + WS_GMA);
    bf16* TB = (bf16*)(ws + WS_T); bf16* X1B = (bf16*)(ws + WS_X1B); bf16* ACT = (bf16*)(ws + WS_ACT); float* SSQ2 = (float*)(ws + WS_SSQ2);

    if (IN(0)) { p0_prologue(F, args); if (BOTH(0)) GRID_BAR(); }
    if (IN(1)) {
        pg8::Gemm g{H1, (const bf16*)(ws + WS_W1T), M, NPROJ, D}; pg8::StaticOrder S; S.init(M, NPROJ, F.G, (int)blockIdx.x);
        pg8::EpiProj E{MQK, MVO, AQ, AKV, GMA};
        pg8::gemm_phase<pg8::EpiProj, pg8::StaticOrder, PG8_ALIGN, PG8_SP2>(F.lds + RING_OFF, g, S, E);
        if (BOTH(1)) GRID_BAR();
    }
    if (IN(2)) { if (BOTH(2)) GRID_BAR(); }
    if (IN(3)) { p3_ymnorm(F, YM); if (BOTH(3)) GRID_BAR(); }
    if (IN(4)) {
        pg8::Gemm g{YM, (const bf16*)(ws + WS_WBM), M, D, D}; pg8::StaticOrder S; S.init(M, D, F.G, (int)blockIdx.x);
        pg8::EpiGate<false> E{TB, GMA, args.in[10]};
        pg8::gemm_phase<pg8::EpiGate<false>, pg8::StaticOrder, PG8_ALIGN, PG8_SP2>(F.lds + RING_OFF, g, S, E);
        if (BOTH(4)) GRID_BAR();
    }
    if (IN(5)) {
        pg8::Gemm g{YA, (const bf16*)(ws + WS_WBA), M, D, D}; pg8::StaticOrder S; S.init(M, D, F.G, (int)blockIdx.x);
        pg8::EpiGate<true> E{TB, GMA + 1024, args.in[10] + 1024};
        pg8::gemm_phase<pg8::EpiGate<true>, pg8::StaticOrder, PG8_ALIGN, PG8_SP2>(F.lds + RING_OFF, g, S, E);
        if (BOTH(5)) GRID_BAR();
    }
    if (IN(6)) {
        pg8::Gemm g{TB, (const bf16*)(ws + WS_WOUT), M, D, D}; pg8::PanelOrder S; S.init(M, D, F.G, (int)blockIdx.x);
        pg8::EpiX1 E{args.in[0], args.out, X1B, SSQ2, {}};
        pg8::gemm_phase<pg8::EpiX1, pg8::PanelOrder, PG8_ALIGN, PG8_SP2>(F.lds + RING_OFF, g, S, E);
        if (BOTH(6)) GRID_BAR();
    }
    if (IN(7)) {
        pg8::Gemm g{X1B, (const bf16*)(ws + WS_WFI), M, NFF2, D}; pg8::StaticOrder S; S.init(M, NFF2, F.G, (int)blockIdx.x);
        pg8::EpiSwiGLU E{SSQ2, ACT, EPS};
        pg8::gemm_phase<pg8::EpiSwiGLU, pg8::StaticOrder, PG8_ALIGN, PG8_SP2>(F.lds + RING_OFF, g, S, E);
        if (BOTH(7)) GRID_BAR();
    }
    if (IN(8)) {
        pg8::Gemm g{ACT, (const bf16*)(ws + WS_WFO), M, D, DFF}; pg8::StaticOrder S; S.init(M, D, F.G, (int)blockIdx.x);
        pg8::EpiOut E{args.out};
        pg8::gemm_phase<pg8::EpiOut, pg8::StaticOrder, PG8_ALIGN, PG8_SP2>(F.lds + RING_OFF, g, S, E);
    }
#undef IN
#undef BOTH
#undef GRID_BAR
}

extern "C" void kernel_launch(void* const* d_in, const int* in_sizes, int n_in, void* d_out, int out_size, void* d_ws, size_t ws_size, hipStream_t stream) {
    static int grid = 0;
    if (grid == 0) {
        if (n_in != 17 || in_sizes[0] != M * D || out_size != M * D || ws_size < WS_END) { fprintf(stderr, "kernel_launch: unexpected shapes / workspace (n_in %d, in0 %d, out %d, ws %zu)\n", n_in, n_in > 0 ? in_sizes[0] : -1, out_size, ws_size); grid = -1; return; }
        int dev = 0, cus = 0;
        if (hipGetDevice(&dev) != hipSuccess || hipDeviceGetAttribute(&cus, hipDeviceAttributeMultiprocessorCount, dev) != hipSuccess) { grid = -1; return; }
        grid = cus;
    }
    if (grid < 0) return;
    (void)hipMemsetAsync((char*)d_ws + WS_CTL, 0, CTL_ZERO_BYTES, stream);
    Args a{};
    for (int i = 0; i < 17; ++i) a.in[i] = (const float*)d_in[i];
    a.out = (float*)d_out; a.ws = (unsigned char*)d_ws;
    unsigned char* ws = (unsigned char*)d_ws;
    auto run = [&](int lo, int hi) { a.ph_lo = lo; a.ph_hi = hi; hipLaunchKernelGGL(fwd, dim3(grid), dim3(NWAVES * 64), 0, stream, a); };
    run(0, 1); run(1, 2);
    hipLaunchKernelGGL(k_mlstm_naive, dim3(256), dim3(256), 0, stream, (const bf16*)(ws + WS_MQK), (const bf16*)(ws + WS_MVO), (const float*)(ws + WS_GATES), (const float*)d_in[3], (const float*)d_in[4], (bf16*)d_out);
    hipLaunchKernelGGL(k_knorm_naive, dim3(M * 2 / 256), dim3(256), 0, stream, (const bf16*)(ws + WS_AKV), (const float*)d_in[8], (const float2*)(ws + WS_ROPE), (float*)(ws + WS_KN));
    hipLaunchKernelGGL(k_attn_naive, dim3(M * 16 / 256), dim3(256), 0, stream, (const bf16*)(ws + WS_AQ), (const bf16*)(ws + WS_AKV), (const float*)(ws + WS_KN), (const float*)d_in[7], (const float*)d_in[9], (const float2*)(ws + WS_ROPE), (bf16*)((unsigned char*)d_out + DO_YA));
    for (int p = 3; p < 9; ++p) run(p, p + 1);
}
```

```cpp
#include <hip/hip_runtime.h>
#include <cstdio>
#include <cstdint>
namespace pg8 {
#define PG8_LAS __attribute__((address_space(3)))
typedef unsigned short bf16_t;
typedef short bf16x8 __attribute__((ext_vector_type(8)));
typedef float f32x4 __attribute__((ext_vector_type(4)));
typedef unsigned u32x4 __attribute__((ext_vector_type(4)));
constexpr int BM = 256, BK = 64, HALF = 128, HTB = HALF * BK * 2  , STAGE_BYTES = 8 * HTB, NXCD = 8, WGM = 4;

__host__ __device__ __forceinline__ int lds_byte(int r, int c) { const int st = (r >> 4) * 2 + (c >> 5), rr = r & 15, cc = c & 31, ob = rr * 64 + cc * 2; return st * 1024 + (ob ^ (((ob >> 9) & 1) << 5)); }
__host__ __device__ __forceinline__ void stage_rc(int b, int& R, int& C) { const int st = b / 1024, sb = b % 1024, swz = sb ^ (((sb >> 9) & 1) << 5); R = (st >> 1) * 16 + swz / 64; C = (st & 1) * 32 + (swz % 64) / 2; }
__host__ __device__ __forceinline__ int perm32(int rho) { const int n = rho >> 4, i = rho & 15; return 8 * (i >> 2) + 4 * n + (i & 3); }

struct Unit { int pm, pn; };
struct Gemm { const bf16_t* A; const bf16_t* Bt; int M, N, K, lda, ldb; };

struct StaticOrder {
    int nM, nN, nwg, G, c;
    __host__ __device__ void init(int M, int N, int G_, int c_) { nM = M / BM; nN = N / BM; nwg = nM * nN; G = G_; c = c_; }
    __host__ __device__ bool next(int i, Unit& u) const {
        const long L = (long)i * G + c; if (L >= nwg) return false;
        int wgid = (int)L; { const int q = nwg / NXCD, r = nwg % NXCD, xcd = wgid % NXCD, off = wgid / NXCD; wgid = (xcd < r ? xcd * (q + 1) : r * (q + 1) + (xcd - r) * q) + off; }
        const int nig = WGM * nN, gid = wgid / nig, fm = gid * WGM, gsz = (nM - fm) < WGM ? (nM - fm) : WGM;
        u.pm = fm + ((wgid % nig) % gsz); u.pn = (wgid % nig) / gsz; return true;
    }
    __device__ __forceinline__ void a_ready(const Unit&) const {}
    __device__ __forceinline__ void done(const Unit&) const {}
};
__device__ __forceinline__ unsigned cvt_pk_bf16(float lo, float hi) { unsigned r; asm volatile("v_cvt_pk_bf16_f32 %0, %1, %2" : "=v"(r) : "v"(lo), "v"(hi)); return r; }
typedef float f32x2 __attribute__((ext_vector_type(2)));

__device__ __forceinline__ float bf_lo(unsigned w) { return __uint_as_float(w << 16); }
__device__ __forceinline__ float bf_hi(unsigned w) { return __uint_as_float(w & 0xffff0000u); }
__device__ __forceinline__ float sigmoid_f(float x) { return __builtin_amdgcn_rcpf(1.0f + __expf(-x)); }
__device__ __forceinline__ unsigned cvt_pk_vis(float lo, float hi) { typedef float f2_t __attribute__((ext_vector_type(2))); typedef __bf16 b2_t __attribute__((ext_vector_type(2)));
    f2_t v = {lo, hi}; b2_t b = __builtin_convertvector(v, b2_t); return __builtin_bit_cast(unsigned, b); }

struct EpiProj {
    static constexpr bool PERM = true, AFTER_DRAIN = false, HAS_MID = false;
    bf16_t *mqk, *mvo, *aq, *akv, *gma; const float* bmerge;
    __device__ __forceinline__ void operator()(const f32x4 (&acc)[2][2][4][2], const Unit& u, int wr, int wc, int fr, int fq) const {
        const int pn = u.pn; const int row0 = u.pm * BM + wr * 64 + fr;
        if (pn < 21) {
            bf16_t* base; int ld, colt;
            if (pn < 8) { base = mqk; ld = 2048; colt = pn * 256; }
            else if (pn < 16) { base = mvo; ld = 2048; colt = (pn - 8) * 256; }
            else if (pn < 20) { base = aq; ld = 1024; colt = (pn - 16) * 256; }
            else { base = akv; ld = 256; colt = 0; }
            const int col0 = colt + wc * 32 + 8 * fq;
#pragma unroll
            for (int ai = 0; ai < 2; ++ai)
#pragma unroll
                for (int m = 0; m < 4; ++m) { bf16_t* rowp = base + (size_t)(row0 + ai * HALF + m * 16) * ld + col0;
#pragma unroll
                    for (int bj = 0; bj < 2; ++bj) { const f32x4 v0 = acc[ai][bj][m][0], v1 = acc[ai][bj][m][1];
                        u32x4 w; w.x = cvt_pk_bf16(v0[0], v0[1]); w.y = cvt_pk_bf16(v0[2], v0[3]); w.z = cvt_pk_bf16(v1[0], v1[1]); w.w = cvt_pk_bf16(v1[2], v1[3]);
                        *(u32x4*)(rowp + bj * HALF) = w; } }
        } else {
            const int col0 = (pn - 21) * HALF + wc * 32 + 8 * fq;
            f32x4 bm[2], ba[2];
#pragma unroll
            for (int n = 0; n < 2; ++n) { bm[n] = *(const f32x4*)(bmerge + col0 + 4 * n); ba[n] = *(const f32x4*)(bmerge + 1024 + col0 + 4 * n); }
#pragma unroll
            for (int ai = 0; ai < 2; ++ai)
#pragma unroll
                for (int m = 0; m < 4; ++m) { bf16_t* rowp = gma + (size_t)(row0 + ai * HALF + m * 16) * 2048 + col0;
                    float gs[8], gr[8];
#pragma unroll
                    for (int j = 0; j < 8; ++j) { const float em = __expf(-fminf(fmaxf(acc[ai][0][m][j >> 2][j & 3] + bm[j >> 2][j & 3], -60.0f), 60.0f)), ea = __expf(-fminf(fmaxf(acc[ai][1][m][j >> 2][j & 3] + ba[j >> 2][j & 3], -60.0f), 60.0f));
                        gs[j] = __builtin_amdgcn_rcpf(1.0f + em); gr[j] = (1.0f + em) * __builtin_amdgcn_rcpf(1.0f + ea); }
                    u32x4 w; w.x = cvt_pk_vis(gs[0], gs[1]); w.y = cvt_pk_vis(gs[2], gs[3]); w.z = cvt_pk_vis(gs[4], gs[5]); w.w = cvt_pk_vis(gs[6], gs[7]);
                    *(u32x4*)rowp = w;
                    w.x = cvt_pk_vis(gr[0], gr[1]); w.y = cvt_pk_vis(gr[2], gr[3]); w.z = cvt_pk_vis(gr[4], gr[5]); w.w = cvt_pk_vis(gr[6], gr[7]);
                    *(u32x4*)(rowp + 1024) = w; }
        }
    }
};
struct EpiGate2 {
    static constexpr bool PERM = true, AFTER_DRAIN = false, HAS_MID = true;
    bf16_t* T; const bf16_t* G;
    __device__ __forceinline__ void mid(f32x4 (&acc)[2][2][4][2], const Unit& u, int wr, int wc, int fr, int fq) const {
        const int row0 = u.pm * BM + wr * 64 + fr, col0 = u.pn * BM + wc * 32 + 8 * fq;
        u32x4 gc, gn;
        gc = *(const u32x4*)(G + (size_t)row0 * 2048 + 1024 + col0);
#pragma unroll
        for (int st = 0; st < 16; ++st) { const int bj = st >> 3, gi = st & 7, ai = gi >> 2, m = gi & 3;
            if (st < 15) { const int bjn = (st + 1) >> 3, gin = (st + 1) & 7; gn = *(const u32x4*)(G + (size_t)(row0 + (gin >> 2) * HALF + (gin & 3) * 16) * 2048 + 1024 + col0 + bjn * HALF); }
            acc[ai][bj][m][0][0] *= bf_lo(gc.x); acc[ai][bj][m][0][1] *= bf_hi(gc.x); acc[ai][bj][m][0][2] *= bf_lo(gc.y); acc[ai][bj][m][0][3] *= bf_hi(gc.y);
            acc[ai][bj][m][1][0] *= bf_lo(gc.z); acc[ai][bj][m][1][1] *= bf_hi(gc.z); acc[ai][bj][m][1][2] *= bf_lo(gc.w); acc[ai][bj][m][1][3] *= bf_hi(gc.w);
            if (st < 15) gc = gn; }
    }
    __device__ __forceinline__ void operator()(const f32x4 (&acc)[2][2][4][2], const Unit& u, int wr, int wc, int fr, int fq) const {
        const int row0 = u.pm * BM + wr * 64 + fr, col0 = u.pn * BM + wc * 32 + 8 * fq;
        u32x4 gc, gn;
        gc = *(const u32x4*)(G + (size_t)row0 * 2048 + col0);
#pragma unroll
        for (int st = 0; st < 16; ++st) { const int bj = st >> 3, gi = st & 7, ai = gi >> 2, m = gi & 3;
            if (st < 15) { const int bjn = (st + 1) >> 3, gin = (st + 1) & 7; gn = *(const u32x4*)(G + (size_t)(row0 + (gin >> 2) * HALF + (gin & 3) * 16) * 2048 + col0 + bjn * HALF); }
            const f32x4 v0 = acc[ai][bj][m][0], v1 = acc[ai][bj][m][1];
            u32x4 w; w.x = cvt_pk_bf16(v0[0] * bf_lo(gc.x), v0[1] * bf_hi(gc.x)); w.y = cvt_pk_bf16(v0[2] * bf_lo(gc.y), v0[3] * bf_hi(gc.y));
            w.z = cvt_pk_bf16(v1[0] * bf_lo(gc.z), v1[1] * bf_hi(gc.z)); w.w = cvt_pk_bf16(v1[2] * bf_lo(gc.w), v1[3] * bf_hi(gc.w));
            *(u32x4*)(T + (size_t)(row0 + ai * HALF + m * 16) * 1024 + col0 + bj * HALF) = w;
            if (st < 15) gc = gn; }
    }
};
struct PanelOrder {
    int nM, nN, G, c;
    __host__ __device__ void init(int M, int N, int G_, int c_) { nM = M / BM; nN = N / BM; G = G_; c = c_; }
    __host__ __device__ bool next(int i, Unit& u) const { const int pm = c + (i / nN) * G; if (pm >= nM) return false; u.pm = pm; u.pn = i % nN; return true; }
    __device__ __forceinline__ void a_ready(const Unit&) const {}
    __device__ __forceinline__ void done(const Unit&) const {}
};
struct EpiX1 {
    static constexpr bool PERM = false, AFTER_DRAIN = false, HAS_MID = false;
    const float* x; bf16_t* x1b; float* ssq; mutable float part[8];
    __device__ __forceinline__ void operator()(const f32x4 (&acc)[2][2][4][2], const Unit& u, int wr, int wc, int fr, int fq) const {
        const int row0 = u.pm * BM + wr * 64 + fr, col0 = u.pn * BM + wc * 32 + 4 * fq;
        if (u.pn == 0) {
#pragma unroll
            for (int gi = 0; gi < 8; ++gi) part[gi] = 0.f; }
#pragma unroll
        for (int ai = 0; ai < 2; ++ai) {
            f32x4 xv[4][4];
#pragma unroll
            for (int m = 0; m < 4; ++m)
#pragma unroll
                for (int q = 0; q < 4; ++q) xv[m][q] = *(const f32x4*)(x + (size_t)(row0 + ai * HALF + m * 16) * 1024 + col0 + (q >> 1) * HALF + (q & 1) * 16);
#pragma unroll
            for (int m = 0; m < 4; ++m) { const size_t r = (size_t)(row0 + ai * HALF + m * 16); float s = 0.f;
#pragma unroll
                for (int q = 0; q < 4; ++q) { const size_t o = r * 1024 + col0 + (q >> 1) * HALF + (q & 1) * 16;
                    const f32x4 v = xv[m][q] + acc[ai][q >> 1][m][q & 1];
                    s += (v[0] * v[0] + v[1] * v[1]) + (v[2] * v[2] + v[3] * v[3]);
                    uint2 w; w.x = cvt_pk_bf16(v[0], v[1]); w.y = cvt_pk_bf16(v[2], v[3]); *(uint2*)(x1b + o) = w; }
                part[ai * 4 + m] += s; } }
        if (u.pn == 3) {
#pragma unroll
            for (int gi = 0; gi < 8; ++gi) { float s = part[gi]; s += __shfl_xor(s, 16); s += __shfl_xor(s, 32);
                if (fq == 0) ssq[(size_t)(row0 + (gi >> 2) * HALF + (gi & 3) * 16) * 4 + wc] = s; } }
    }
};
struct EpiSwiGLU {
    static constexpr bool PERM = true, AFTER_DRAIN = false, HAS_MID = false;
    const float* ssq; bf16_t* act; float eps;
    __device__ __forceinline__ void operator()(const f32x4 (&acc)[2][2][4][2], const Unit& u, int wr, int wc, int fr, int fq) const {
        const int row0 = u.pm * BM + wr * 64 + fr, col0 = u.pn * HALF + wc * 32 + 8 * fq;
        float rs[8];
#pragma unroll
        for (int gi = 0; gi < 8; ++gi) { const f32x4 s = *(const f32x4*)(ssq + (size_t)(row0 + (gi >> 2) * HALF + (gi & 3) * 16) * 4);
            rs[gi] = __builtin_amdgcn_rsqf(((s[0] + s[1]) + (s[2] + s[3])) * (1.0f / 1024.0f) + eps); }
#pragma unroll
        for (int gi = 0; gi < 8; ++gi) { const int ai = gi >> 2, m = gi & 3; const size_t r = (size_t)(row0 + ai * HALF + m * 16); const float rstd = rs[gi];
            float a[8];
#pragma unroll
            for (int n = 0; n < 2; ++n)
#pragma unroll
                for (int j = 0; j < 4; ++j) { const float g = rstd * acc[ai][0][m][n][j], up = rstd * acc[ai][1][m][n][j]; a[4 * n + j] = g * sigmoid_f(g) * up; }
            u32x4 w; w.x = cvt_pk_bf16(a[0], a[1]); w.y = cvt_pk_bf16(a[2], a[3]); w.z = cvt_pk_bf16(a[4], a[5]); w.w = cvt_pk_bf16(a[6], a[7]);
            *(u32x4*)(act + r * 2816 + col0) = w; }
    }
};
struct EpiOut {
    static constexpr bool PERM = false, AFTER_DRAIN = false, HAS_MID = false;
    const bf16_t* x1b; float* out;
    __device__ __forceinline__ void operator()(const f32x4 (&acc)[2][2][4][2], const Unit& u, int wr, int wc, int fr, int fq) const {
        const int row0 = u.pm * BM + wr * 64 + fr, col0 = u.pn * BM + wc * 32 + 4 * fq;
#pragma unroll
        for (int ai = 0; ai < 2; ++ai) {
            uint2 xv[4][4];
#pragma unroll
            for (int m = 0; m < 4; ++m)
#pragma unroll
                for (int q = 0; q < 4; ++q) xv[m][q] = *(const uint2*)(x1b + (size_t)(row0 + ai * HALF + m * 16) * 1024 + col0 + (q >> 1) * HALF + (q & 1) * 16);
#pragma unroll
            for (int m = 0; m < 4; ++m) { const size_t r = (size_t)(row0 + ai * HALF + m * 16);
#pragma unroll
                for (int q = 0; q < 4; ++q) { const f32x4 a = acc[ai][q >> 1][m][q & 1]; f32x4 o; o[0] = bf_lo(xv[m][q].x) + a[0]; o[1] = bf_hi(xv[m][q].x) + a[1]; o[2] = bf_lo(xv[m][q].y) + a[2]; o[3] = bf_hi(xv[m][q].y) + a[3];
                    *(f32x4*)(out + r * 1024 + col0 + (q >> 1) * HALF + (q & 1) * 16) = o; } } }
    }
};

template <class Epi, class Sched, bool ALIGN_EPI = false, bool SP2 = false>
__device__ __forceinline__ void gemm_phase(PG8_LAS unsigned char* lds, const Gemm g, const Sched& S, const Epi& E) {
    const int tid = threadIdx.x, wid = __builtin_amdgcn_readfirstlane(tid >> 6), lane = tid & 63, wr = wid >> 2, wc = wid & 3, fr = lane & 15, fq = lane >> 4;
    const int K = g.K, nt = K / BK;
    unsigned voffA[2], voffB[2];
#pragma unroll
    for (int i = 0; i < 2; ++i) { int R, C; stage_rc(tid * 16 + i * 8192, R, C); const int Rb = Epi::PERM ? ((R & ~31) + perm32(R & 31)) : R;
        voffA[i] = (unsigned)(R * g.lda + C) * 2u; voffB[i] = (unsigned)(Rb * g.ldb + C) * 2u; }
    const size_t kstep = (size_t)(BK * 2);
    const size_t hstepA = (size_t)HALF * g.lda * 2, hstepB = (size_t)HALF * g.ldb * 2;
    const size_t tstepA = 2 * hstepA, tstepB = 2 * hstepB;
    const unsigned ldsw = (unsigned)wid * 1024u;
    const int aoff = lds_byte(wr * 64 + fr, fq * 8), boff = lds_byte(wc * 32 + fr, fq * 8);
#define PG8_SA(b, h) (((b) * 2 + (h)) * HTB)
#define PG8_SB(b, h) ((4 + (b) * 2 + (h)) * HTB)
#define PG8_STAGE(bufoff, gbase, voff) do { _Pragma("unroll") for (int _i = 0; _i < 2; ++_i) \
        __builtin_amdgcn_global_load_lds((const unsigned*)((const char*)(gbase) + (voff)[_i]), (PG8_LAS unsigned*)(lds + (bufoff) + ldsw + _i * 8192), 16, 0, 0); } while (0)
#define PG8_LDA(dst, b, h) do { _Pragma("unroll") for (int m = 0; m < 4; ++m) _Pragma("unroll") for (int k = 0; k < 2; ++k) dst[m][k] = *(const PG8_LAS bf16x8*)(lds + PG8_SA(b, h) + aoff + m * 2048 + k * 1024); } while (0)
#define PG8_LDB(dst, b, h) do { _Pragma("unroll") for (int n = 0; n < 2; ++n) _Pragma("unroll") for (int k = 0; k < 2; ++k) dst[n][k] = *(const PG8_LAS bf16x8*)(lds + PG8_SB(b, h) + boff + n * 2048 + k * 1024); } while (0)
#define PG8_MMA(ai, bj, At, Bt) do { __builtin_amdgcn_s_setprio(1); _Pragma("unroll") for (int m = 0; m < 4; ++m) _Pragma("unroll") for (int n = 0; n < 2; ++n) _Pragma("unroll") for (int k = 0; k < 2; ++k) \
        acc[ai][bj][m][n] = __builtin_amdgcn_mfma_f32_16x16x32_bf16(Bt[n][k], At[m][k], acc[ai][bj][m][n], 0, 0, 0); __builtin_amdgcn_s_setprio(0); } while (0)
#define PG8_WAIT_V(n) asm volatile("s_waitcnt vmcnt(" #n ")" ::: "memory")
#define PG8_WAIT_L(n) asm volatile("s_waitcnt lgkmcnt(" #n ")" ::: "memory")
#define PG8_BAR __builtin_amdgcn_s_barrier()
#define PG8_SCHED __builtin_amdgcn_sched_barrier(0)
    Unit cur, nxt; int ui = 0;
    if (!S.next(0, cur)) return;
    f32x4 acc[2][2][4][2];
#pragma unroll
    for (int a = 0; a < 2; ++a)
#pragma unroll
        for (int b = 0; b < 2; ++b)
#pragma unroll
            for (int m = 0; m < 4; ++m)
#pragma unroll
                for (int n = 0; n < 2; ++n) acc[a][b][m][n] = (f32x4){0.f, 0.f, 0.f, 0.f};
    bf16x8 At[4][2], B0[2][2], B1[2][2];
    const char* cA = (const char*)g.A + (size_t)cur.pm * tstepA; const char* cB = (const char*)g.Bt + (size_t)cur.pn * tstepB;
    S.a_ready(cur);
    if constexpr (SP2) {
        PG8_STAGE(PG8_SB(0, 0), cB, voffB); PG8_STAGE(PG8_SB(0, 1), cB + hstepB, voffB); PG8_STAGE(PG8_SA(0, 0), cA, voffA); PG8_STAGE(PG8_SA(0, 1), cA + hstepA, voffA);
        if (wr == 1) PG8_BAR;
        PG8_WAIT_V(2); PG8_BAR;
        PG8_STAGE(PG8_SB(1, 0), cB + kstep, voffB); PG8_STAGE(PG8_SA(1, 0), cA + kstep, voffA); PG8_STAGE(PG8_SB(1, 1), cB + hstepB + kstep, voffB);
        PG8_WAIT_V(6); PG8_BAR;
    } else {
        PG8_STAGE(PG8_SB(0, 0), cB, voffB); PG8_STAGE(PG8_SA(0, 0), cA, voffA); PG8_STAGE(PG8_SB(0, 1), cB + hstepB, voffB); PG8_STAGE(PG8_SA(0, 1), cA + hstepA, voffA);
        if (wr == 1) PG8_BAR;
        PG8_WAIT_V(4); PG8_BAR;
        PG8_STAGE(PG8_SB(1, 0), cB + kstep, voffB); PG8_STAGE(PG8_SA(1, 0), cA + kstep, voffA); PG8_STAGE(PG8_SB(1, 1), cB + hstepB + kstep, voffB);
        PG8_WAIT_V(6); PG8_BAR;
    }
    for (;;) {
        const bool has_next = S.next(ui + 1, nxt);
        const char* nA = has_next ? (const char*)g.A + (size_t)nxt.pm * tstepA : cA; const char* nB = has_next ? (const char*)g.Bt + (size_t)nxt.pn * tstepB : cB;
        for (int t = 0; t < nt; t += 2) {
            const bool last = (t == nt - 2);
            const char* a1 = cA + (size_t)(t + 1) * kstep;
            const char* a2 = last ? nA : cA + (size_t)(t + 2) * kstep; const char* b2 = last ? nB : cB + (size_t)(t + 2) * kstep;
            const char* a3 = a2 + kstep; const char* b3 = b2 + kstep;
            if (last && has_next) S.a_ready(nxt);
            if constexpr (Epi::HAS_MID) { if (t == (nt >> 1)) E.mid(acc, cur, wr, wc, fr, fq); }
            if constexpr (SP2) {
            PG8_LDB(B0, 0, 0); PG8_LDB(B1, 0, 1); PG8_SCHED; PG8_LDA(At, 0, 0); PG8_STAGE(PG8_SA(1, 1), a1 + hstepA, voffA);
            PG8_WAIT_V(8); PG8_WAIT_L(0); PG8_BAR; PG8_MMA(0, 0, At, B0); PG8_MMA(0, 1, At, B1); PG8_BAR; PG8_SCHED;
            PG8_LDA(At, 0, 1); PG8_STAGE(PG8_SB(0, 0), b2, voffB); PG8_STAGE(PG8_SB(0, 1), b2 + hstepB, voffB); PG8_STAGE(PG8_SA(0, 0), a2, voffA);
            PG8_WAIT_V(8); PG8_WAIT_L(0); PG8_BAR; PG8_MMA(1, 0, At, B0); PG8_MMA(1, 1, At, B1); PG8_BAR; PG8_SCHED;
            PG8_LDB(B0, 1, 0); PG8_LDB(B1, 1, 1); PG8_SCHED; PG8_LDA(At, 1, 0); PG8_STAGE(PG8_SA(0, 1), a2 + hstepA, voffA);
            PG8_WAIT_V(8); PG8_WAIT_L(0); PG8_BAR; PG8_MMA(0, 0, At, B0); PG8_MMA(0, 1, At, B1); PG8_BAR; PG8_SCHED;
            PG8_LDA(At, 1, 1); PG8_STAGE(PG8_SB(1, 0), b3, voffB); PG8_STAGE(PG8_SB(1, 1), b3 + hstepB, voffB); PG8_STAGE(PG8_SA(1, 0), a3, voffA);
            PG8_WAIT_V(8); PG8_WAIT_L(0); PG8_BAR; PG8_MMA(1, 0, At, B0); PG8_MMA(1, 1, At, B1); PG8_BAR; PG8_SCHED;
            } else {
            PG8_LDB(B0, 0, 0); PG8_SCHED; PG8_LDA(At, 0, 0); PG8_STAGE(PG8_SA(1, 1), a1 + hstepA, voffA);
            PG8_WAIT_L(8); PG8_BAR; PG8_WAIT_L(0); PG8_MMA(0, 0, At, B0); PG8_BAR; PG8_SCHED;
            PG8_LDB(B1, 0, 1); PG8_STAGE(PG8_SB(0, 0), b2, voffB);
            PG8_BAR; PG8_WAIT_L(0); PG8_MMA(0, 1, At, B1); PG8_BAR;
            PG8_LDA(At, 0, 1); PG8_STAGE(PG8_SA(0, 0), a2, voffA);
            PG8_BAR; PG8_WAIT_L(0); PG8_MMA(1, 0, At, B0); PG8_BAR; PG8_SCHED;
            PG8_STAGE(PG8_SB(0, 1), b2 + hstepB, voffB);
            PG8_WAIT_V(6); PG8_BAR; PG8_MMA(1, 1, At, B1); PG8_BAR;
            PG8_LDB(B0, 1, 0); PG8_SCHED; PG8_LDA(At, 1, 0); PG8_STAGE(PG8_SA(0, 1), a2 + hstepA, voffA);
            PG8_WAIT_L(8); PG8_BAR; PG8_WAIT_L(0); PG8_MMA(0, 0, At, B0); PG8_BAR; PG8_SCHED;
            PG8_LDB(B1, 1, 1); PG8_STAGE(PG8_SB(1, 0), b3, voffB);
            PG8_BAR; PG8_WAIT_L(0); PG8_MMA(0, 1, At, B1); PG8_BAR;
            PG8_LDA(At, 1, 1); PG8_STAGE(PG8_SA(1, 0), a3, voffA);
            PG8_BAR; PG8_WAIT_L(0); PG8_MMA(1, 0, At, B0); PG8_BAR; PG8_SCHED;
            PG8_STAGE(PG8_SB(1, 1), b3 + hstepB, voffB);
            PG8_WAIT_V(6); PG8_BAR; PG8_MMA(1, 1, At, B1); PG8_BAR;
            }
        }
        if constexpr (ALIGN_EPI) { if (wr == 0) PG8_BAR; }
        if constexpr (!Epi::AFTER_DRAIN) { E(acc, cur, wr, wc, fr, fq); S.done(cur); }
        if (!has_next) break;
#pragma unroll
        for (int a = 0; a < 2; ++a)
#pragma unroll
            for (int b = 0; b < 2; ++b)
#pragma unroll
                for (int m = 0; m < 4; ++m)
#pragma unroll
                    for (int n = 0; n < 2; ++n) acc[a][b][m][n] = (f32x4){0.f, 0.f, 0.f, 0.f};
        cur = nxt; cA = nA; cB = nB; ++ui;
        if constexpr (ALIGN_EPI) { if (wr == 1) PG8_BAR; }
    }
    PG8_WAIT_V(0);
    if constexpr (!ALIGN_EPI) { if (wr == 0) PG8_BAR; }
    PG8_BAR;
    if constexpr (Epi::AFTER_DRAIN) { E.fused(acc, cur, wr, wc, fr, fq, lds, wid, lane); S.done(cur); }
#undef PG8_SA
#undef PG8_SB
#undef PG8_STAGE
#undef PG8_LDA
#undef PG8_LDB
#undef PG8_MMA
#undef PG8_WAIT_V
#undef PG8_WAIT_L
#undef PG8_BAR
#undef PG8_SCHED
}
}
#ifndef PG8_SP2
#define PG8_SP2 true
#endif
#ifndef PG8_ALIGN
#define PG8_ALIGN true
#endif
#define GAS __attribute__((address_space(1)))
#define LAS __attribute__((address_space(3)))
typedef unsigned short bf16;
typedef unsigned v4u __attribute__((ext_vector_type(4)));
typedef float f32x4 __attribute__((ext_vector_type(4)));
typedef short bf16x8 __attribute__((ext_vector_type(8)));
typedef GAS unsigned gu32;
typedef GAS unsigned long long gu64;
#define RLX_AGENT __ATOMIC_RELAXED, __HIP_MEMORY_SCOPE_AGENT
#define LDS_WAIT() asm volatile("s_waitcnt lgkmcnt(0)" ::: "memory")
#define VM_WAIT() asm volatile("s_waitcnt vmcnt(0)" ::: "memory")
__device__ __forceinline__ unsigned long long rt() { return __builtin_amdgcn_s_memrealtime(); }
__device__ __forceinline__ unsigned f2bf(float f) { unsigned u = __builtin_bit_cast(unsigned, f); return (u + 0x7fffu + ((u >> 16) & 1u)) >> 16; }
__device__ __forceinline__ unsigned pk2(float lo, float hi) { return f2bf(lo) | (f2bf(hi) << 16); }
#define XB_TMO      128
#define XB_XCNT(j)  (256  + 64 * (j))
#define XB_XSUB(j)  (1280 + 64 * (j))
#define XB_XGEN(j)  (2304 + 64 * (j))
#define XB_TOP      3328
#define XB_TOPGEN   3392
#define XCD_BAR_WORDS 3456
#define XB_SPIN_CAP (1u << 18)

__device__ __forceinline__ unsigned xb_ld(unsigned* p)              { return __hip_atomic_load(p, __ATOMIC_RELAXED, __HIP_MEMORY_SCOPE_AGENT); }
__device__ __forceinline__ unsigned xb_add(unsigned* p, unsigned v) { return __hip_atomic_fetch_add(p, v, __ATOMIC_RELAXED, __HIP_MEMORY_SCOPE_AGENT); }
__device__ __forceinline__ unsigned xb_xcc_id() { return (unsigned)__builtin_amdgcn_s_getreg((3 << 11) | 20) & 0xFu; }
#define XB_SPIN(cond, bar) do { unsigned _sp = 0; while (cond) { __builtin_amdgcn_s_sleep(1); \
    if ((++_sp & 255u) == 0u) { if (xb_ld(&(bar)[XB_TMO])) break; if (_sp > XB_SPIN_CAP) { atomicAdd(&(bar)[XB_TMO], 1u); break; } } } } while (0)

struct XcdBarrier {
    unsigned* bar; unsigned x;
    volatile LAS unsigned* st;
};

__device__ __forceinline__ XcdBarrier xcd_barrier_post(unsigned* bar, volatile LAS unsigned* st) {
    XcdBarrier b; b.bar = bar; b.x = xb_xcc_id(); b.st = st;
    if (threadIdx.x == 0) (void)xb_add(&bar[XB_XCNT(b.x)], 1u);
    return b;
}
__device__ __forceinline__ void xcd_barrier_complete(unsigned* bar, unsigned x, unsigned& nloc, unsigned& nx) {
    const unsigned G = gridDim.x * gridDim.y * gridDim.z;
    unsigned sum, cnt, mine, sp = 0u;
    for (;;) {
        sum = 0u; cnt = 0u; mine = 0u;
#pragma unroll
        for (unsigned j = 0; j < 16; ++j) { const unsigned c = xb_ld(&bar[XB_XCNT(j)]); sum += c; cnt += (c > 0u) ? 1u : 0u; mine = (j == x) ? c : mine; }
        if (sum == G) break;
        __builtin_amdgcn_s_sleep(1);
        if ((++sp & 255u) == 0u) { if (xb_ld(&bar[XB_TMO])) break; if (sp > XB_SPIN_CAP) { atomicAdd(&bar[XB_TMO], 1u); break; } }
    }
    nloc = mine > 0u ? mine : 1u; nx = cnt > 0u ? cnt : 1u;
}

__device__ __forceinline__ void xcd_barrier(const XcdBarrier& b) {
    asm volatile("s_waitcnt vmcnt(0)" ::: "memory");
    __syncthreads();
    if (threadIdx.x == 0) {
        unsigned* bar = b.bar;
        __builtin_amdgcn_s_waitcnt(0);
        unsigned nloc = b.st[0], nx = b.st[1];
        if (nloc == 0u) { xcd_barrier_complete(bar, b.x, nloc, nx); b.st[0] = nloc; b.st[1] = nx; }
        const unsigned old = xb_add(&bar[XB_XSUB(b.x)], 1u);
        const unsigned gen = old / nloc;
        if (old + 1u == (gen + 1u) * nloc) {
            __builtin_amdgcn_fence(__ATOMIC_RELEASE, "agent");
            asm volatile("s_waitcnt vmcnt(0)" ::: "memory");
            const unsigned og = xb_add(&bar[XB_TOP], 1u);
            const unsigned tg = og / nx;
            if (og + 1u == (tg + 1u) * nx) xb_add(&bar[XB_TOPGEN], 1u);
            else XB_SPIN(xb_ld(&bar[XB_TOPGEN]) == tg, bar);
            __builtin_amdgcn_fence(__ATOMIC_ACQUIRE, "agent");
            xb_add(&bar[XB_XGEN(b.x)], 1u);
            asm volatile("s_waitcnt vmcnt(0)" ::: "memory");
        } else {
            XB_SPIN(xb_ld(&bar[XB_XGEN(b.x)]) == gen, bar);
            __builtin_amdgcn_fence(__ATOMIC_ACQUIRE, "agent");
            asm volatile("s_waitcnt vmcnt(0)" ::: "memory");
        }
    }
    __syncthreads();
}

constexpr int NB = 16, SEQ = 4096, D = 1024, M = NB * SEQ;
constexpr int NIN = 7432, NPROJ = 7424, DFF = 2816, NFF2 = 5632;
constexpr float EPS = 1e-6f;
constexpr int NWAVES = 8;
constexpr size_t MiB = 1u << 20;
constexpr size_t WS_CTL = 0, CTL_ZERO_BYTES = 1 * MiB;
constexpr size_t WS_W1T = 2 * MiB, WS_WCAT = 17 * MiB  , WS_WOUT = 21 * MiB, WS_WFI = 23 * MiB, WS_WFO = 34 * MiB;
constexpr size_t WS_GATES = 40 * MiB;
constexpr size_t WS_ROPE = 42 * MiB;
constexpr size_t WS_SSQ2 = 43 * MiB;
constexpr size_t WS_MQK = 48 * MiB, WS_MVO = 304 * MiB, WS_AQ = 560 * MiB, WS_AKV = 688 * MiB, WS_GMA = 720 * MiB;
constexpr size_t WS_CAT = WS_MQK;
constexpr size_t WS_T = WS_MVO;
constexpr size_t WS_X1B = WS_MQK;
constexpr size_t WS_ACT = WS_AQ;
constexpr size_t WS_FREE = 976 * MiB;
constexpr size_t WS_END = 1024 * MiB;
static_assert(WS_W1T + (size_t)NPROJ * D * 2 <= WS_WCAT && WS_WFI + (size_t)NFF2 * D * 2 <= WS_WFO && WS_WFO + (size_t)D * DFF * 2 <= WS_GATES, "weights map");
static_assert(WS_ACT + (size_t)M * DFF * 2 <= WS_FREE && WS_GMA + (size_t)M * 2048 * 2 <= WS_FREE, "ws map");
constexpr int CW_BAR = 4096;
constexpr int RING_OFF = 0, RING_BYTES = 131072, LDSCTL_OFF = RING_BYTES, MISC_OFF = LDSCTL_OFF + 320, LDSCTL_BYTES = 1024, XTRA_OFF = LDSCTL_OFF + LDSCTL_BYTES, LDS_BYTES = 163840;

typedef GAS float gf32;

__device__ __forceinline__ float wave_sum(float v) {
#pragma unroll
    for (int o = 1; o < 64; o <<= 1) v += __shfl_xor(v, o);
    return v;
}
__device__ __forceinline__ float bf2f(bf16 b) { return __uint_as_float(((unsigned)b) << 16); }

struct Frame {
    LAS unsigned char* lds;
    volatile LAS unsigned* MISC;
    gu32* ctl;
    int tid, lane, wave, vcu, G;
};

__device__ __forceinline__ void p0_transpose_item(const float* W, int ldw, int csrc, int K, bf16* WT, int ndst, int k0, const float* rowscale, LAS float* scr, int lane) {
#pragma unroll
    for (int i = 0; i < 32; ++i) { const int kk = 2 * i + (lane >> 5); float v = W[(size_t)(k0 + kk) * ldw + csrc + (lane & 31)]; if (rowscale) v *= rowscale[k0 + kk]; scr[kk * 33 + (lane & 31)] = v; }
    LDS_WAIT(); asm volatile("" ::: "memory");
    const int c = lane & 7;
#pragma unroll
    for (int j = 0; j < 4; ++j) { const int n = (lane >> 3) + 8 * j; const LAS float* s = scr + (8 * c) * 33 + n;
        v4u o; o.x = pk2(s[0 * 33], s[1 * 33]); o.y = pk2(s[2 * 33], s[3 * 33]); o.z = pk2(s[4 * 33], s[5 * 33]); o.w = pk2(s[6 * 33], s[7 * 33]);
        *(GAS v4u*)(WT + (size_t)(ndst + n) * K + k0 + 8 * c) = o; }
    LDS_WAIT(); asm volatile("" ::: "memory");
}

struct Args { const float* in[17]; float* out; unsigned char* ws; int ph_lo, ph_hi, li, pad; };

__device__ __forceinline__ void p0_prologue(Frame& F, const Args& A) {
    unsigned char* ws = A.ws;
    LAS float* scr = (LAS float*)(F.lds + RING_OFF + F.wave * 16384);
    const int gw = F.vcu * NWAVES + F.wave, NGW = F.G * NWAVES;
    constexpr int I_IN = 16 * (NPROJ / 32), I_SQ = 16 * 32, I_FI = 16 * (NFF2 / 32), I_FO = (DFF / 64) * 32;
    constexpr int NITEMS = I_IN + 3 * I_SQ + I_FI + I_FO;
    for (int it = gw; it < NITEMS; it += NGW) {
        int r = it;
        if (r < I_IN) { const int nb = r % (NPROJ / 32), kb = r / (NPROJ / 32), n0 = 32 * nb; int csrc = n0 + (n0 >= 4096 ? 8 : 0);
            if (n0 >= 5376) { const int q = (n0 - 5376) >> 8, c = (n0 - 5376) & 255; csrc = (c < 128) ? 5384 + 128 * q + c : 6408 + 128 * q + (c - 128); }
            p0_transpose_item(A.in[2], NIN, csrc, D, (bf16*)(ws + WS_W1T), n0, 64 * kb, nullptr, scr, F.lane); continue; } r -= I_IN;
        if (r < I_SQ) { p0_transpose_item(A.in[11], D, 32 * (r % 32), 2048, (bf16*)(ws + WS_WCAT) + 1024, 32 * (r % 32), 64 * (r / 32), A.in[6], scr, F.lane); continue; } r -= I_SQ;
        if (r < I_SQ) { p0_transpose_item(A.in[12], D, 32 * (r % 32), 2048, (bf16*)(ws + WS_WCAT), 32 * (r % 32), 64 * (r / 32), nullptr, scr, F.lane); continue; } r -= I_SQ;
        if (r < I_SQ) { p0_transpose_item(A.in[13], D, 32 * (r % 32), D, (bf16*)(ws + WS_WOUT), 32 * (r % 32), 64 * (r / 32), nullptr, scr, F.lane); continue; } r -= I_SQ;
        if (r < I_FI) { const int nb = r % (NFF2 / 32), kb = r / (NFF2 / 32), n0 = 32 * nb, tile = n0 >> 8, c = n0 & 255;
            const int csrc = (c < 128) ? 128 * tile + c : DFF + 128 * tile + (c - 128);
            p0_transpose_item(A.in[15], NFF2, csrc, D, (bf16*)(ws + WS_WFI), n0, 64 * kb, A.in[14], scr, F.lane); continue; } r -= I_FI;
        p0_transpose_item(A.in[16], D, 32 * (r % 32), DFF, (bf16*)(ws + WS_WFO), 32 * (r % 32), 64 * (r / 32), nullptr, scr, F.lane);
    }
    { const int idx = blockIdx.x * (NWAVES * 64) + F.tid;
      if (idx < SEQ * 8) { const int pos = idx >> 3, i = idx & 7;
        const double invf[8] = {1.0, 0.19392274474868576, 0.03760603093086393, 0.007292664737217109, 0.001414213562373095, 0.0002742481756762073, 5.318295896944988e-05, 1.031338537721246e-05};
        double f = invf[0];
#pragma unroll
        for (int q = 1; q < 8; ++q) f = (i == q) ? invf[q] : f;
        double t = (double)pos * f * 0.15915494309189535; t -= __builtin_rint(t);
        float2 cs; cs.x = __builtin_amdgcn_cosf((float)t); cs.y = __builtin_amdgcn_sinf((float)t);
        ((float2*)(ws + WS_ROPE))[idx] = cs; } }
    __syncthreads();
    LAS float* gwa = (LAS float*)(F.lds + RING_OFF); LAS float* gwb = gwa + 4096;
    for (int idx = F.tid; idx < 1024 * 8; idx += NWAVES * 64) { const int k = idx >> 3, c = idx & 7; const float v = A.in[2][(size_t)k * NIN + 4096 + c];
        const int j = k >> 8, ln = (k >> 2) & 63, i = k & 3; LAS float* dst = (c < 4) ? gwa : gwb; dst[((j * 4 + i) * 64 + ln) * 4 + (c & 3)] = v; }
    __syncthreads();
    const float* x = A.in[0]; const float* g1 = A.in[1]; const float* bg = A.in[5];
    bf16* H1 = (bf16*)A.out; float* gates = (float*)(ws + WS_GATES);
    f32x4 gv[4];
#pragma unroll
    for (int j = 0; j < 4; ++j) gv[j] = ((const GAS f32x4*)g1)[F.lane + 64 * j];
    constexpr int RB = 4;
    for (int m0 = gw * RB; m0 < M; m0 += NGW * RB) {
        f32x4 v[RB][4];
#pragma unroll
        for (int rr = 0; rr < RB; ++rr) { const GAS f32x4* xr = (const GAS f32x4*)(x + (size_t)(m0 + rr) * D) + F.lane;
#pragma unroll
            for (int j = 0; j < 4; ++j) v[rr][j] = xr[64 * j]; }
#pragma unroll
        for (int rr = 0; rr < RB; ++rr) { const int m = m0 + rr; float s = 0.f;
#pragma unroll
            for (int j = 0; j < 4; ++j) s += (v[rr][j].x * v[rr][j].x + v[rr][j].y * v[rr][j].y) + (v[rr][j].z * v[rr][j].z + v[rr][j].w * v[rr][j].w);
            const float rstd = 1.0f / sqrtf(wave_sum(s) * (1.0f / D) + EPS);
            GAS unsigned long long* o8 = (GAS unsigned long long*)(H1 + (size_t)m * D) + F.lane;
            float ga[8];
#pragma unroll
            for (int c = 0; c < 8; ++c) ga[c] = 0.f;
#pragma unroll
            for (int j = 0; j < 4; ++j) { const f32x4 hv4 = v[rr][j] * rstd * gv[j];
                o8[64 * j] = (unsigned long long)pk2(hv4.x, hv4.y) | ((unsigned long long)pk2(hv4.z, hv4.w) << 32);
#pragma unroll
                for (int i = 0; i < 4; ++i) { const f32x4 wa = *(const LAS f32x4*)(gwa + ((j * 4 + i) * 64 + F.lane) * 4), wb = *(const LAS f32x4*)(gwb + ((j * 4 + i) * 64 + F.lane) * 4);
                    const float hv = hv4[i];
                    ga[0] += hv * wa[0]; ga[1] += hv * wa[1]; ga[2] += hv * wa[2]; ga[3] += hv * wa[3];
                    ga[4] += hv * wb[0]; ga[5] += hv * wb[1]; ga[6] += hv * wb[2]; ga[7] += hv * wb[3]; } }
            float gh[4];
#pragma unroll
            for (int c = 0; c < 4; ++c) { const float mine = (F.lane < 32) ? ga[c] : ga[4 + c], send = (F.lane < 32) ? ga[4 + c] : ga[c]; gh[c] = mine + __shfl_xor(send, 32); }
#pragma unroll
            for (int c = 0; c < 4; ++c) {
#pragma unroll
                for (int o = 1; o < 32; o <<= 1) gh[c] += __shfl_xor(gh[c], o); }
            if ((F.lane & 31) < 4) { const int c = F.lane & 3; float val = gh[0];
                val = (c == 1) ? gh[1] : val; val = (c == 2) ? gh[2] : val; val = (c == 3) ? gh[3] : val;
                const int gi = (F.lane >> 5) * 4 + c;
                val += bg[gi];
                if (gi >= 4) val = fminf(val, 0.f) - log1pf(__expf(-fabsf(val)));
                gates[(size_t)m * 8 + gi] = val; }
        }
    }
}

__device__ __forceinline__ void unpack8(const v4u w, float* f) {
    f[0] = __uint_as_float(w.x << 16); f[1] = __uint_as_float(w.x & 0xffff0000u); f[2] = __uint_as_float(w.y << 16); f[3] = __uint_as_float(w.y & 0xffff0000u);
    f[4] = __uint_as_float(w.z << 16); f[5] = __uint_as_float(w.z & 0xffff0000u); f[6] = __uint_as_float(w.w << 16); f[7] = __uint_as_float(w.w & 0xffff0000u); }
typedef float f32x16 __attribute__((ext_vector_type(16)));
typedef short s16x4 __attribute__((ext_vector_type(4)));
__device__ __forceinline__ unsigned cvtpk(float lo, float hi) { typedef float f2_t __attribute__((ext_vector_type(2))); typedef __bf16 b2_t __attribute__((ext_vector_type(2)));
    f2_t v = {lo, hi}; b2_t b = __builtin_convertvector(v, b2_t); return __builtin_bit_cast(unsigned, b); }
__device__ __forceinline__ int crow(int r, int hi) { return (r & 3) + 8 * (r >> 2) + 4 * hi; }
__device__ __forceinline__ bf16x8 tr_pair(const LAS unsigned char* p, int hi_off) {
    const s16x4 lo = __builtin_bit_cast(s16x4, __builtin_amdgcn_ds_read_tr16_b64_v4i16((LAS s16x4*)(p)));
    const s16x4 hi = __builtin_bit_cast(s16x4, __builtin_amdgcn_ds_read_tr16_b64_v4i16((LAS s16x4*)(p + hi_off)));
    return (bf16x8){lo[0], lo[1], lo[2], lo[3], hi[0], hi[1], hi[2], hi[3]}; }
constexpr int AT_KPITCH = 144, AT_K_OFF = 0, AT_V_OFF = 256 * AT_KPITCH, AT_VBLK = 256 * 64, AT_OST_OFF = AT_V_OFF + 2 * AT_VBLK, AT_UNITS = NB * 2 * (SEQ / 128);
static_assert(AT_OST_OFF + 8 * 4096 <= RING_BYTES, "attention LDS");

__device__ __forceinline__ void attn_phase(Frame& F, const bf16* AQ, const bf16* AKV, const float* qg, const float* kg, const float* sinks, const float2* rope, bf16* YA, bf16* YMN) {
    LAS unsigned char* L = F.lds + RING_OFF;
    const int lane = F.lane, r = lane & 31, h = lane >> 5, w = F.wave;
    const int lrow = F.tid >> 1, lhalf = F.tid & 1;
    const int per = (AT_UNITS + F.G - 1) / F.G;
    for (int it = 0; it < per; ++it) {
        const int unit = F.vcu * per + it; if (unit >= AT_UNITS) break;
        const int b = unit >> 6, kvh = (unit >> 5) & 1, qblk = unit & 31, q0 = qblk * 128;
        {
            const int kpos = q0 - 128 + lrow; const bool valid = kpos >= 0; const int kpc = valid ? kpos : 0;
            const size_t rowg = (size_t)b * SEQ + kpc;
            const GAS v4u* ks = (const GAS v4u*)(AKV + rowg * 256 + kvh * 64 + lhalf * 32);
            const GAS v4u* vs = (const GAS v4u*)(AKV + rowg * 256 + 128 + kvh * 64 + lhalf * 32);
            v4u kw[4], vw[4];
#pragma unroll
            for (int q = 0; q < 4; ++q) { kw[q] = ks[q]; vw[q] = vs[q]; }
            float y[32]; float ss = 0.f;
#pragma unroll
            for (int q = 0; q < 4; ++q) {
                y[8 * q + 0] = __uint_as_float(kw[q].x << 16); y[8 * q + 1] = __uint_as_float(kw[q].x & 0xffff0000u); y[8 * q + 2] = __uint_as_float(kw[q].y << 16); y[8 * q + 3] = __uint_as_float(kw[q].y & 0xffff0000u);
                y[8 * q + 4] = __uint_as_float(kw[q].z << 16); y[8 * q + 5] = __uint_as_float(kw[q].z & 0xffff0000u); y[8 * q + 6] = __uint_as_float(kw[q].w << 16); y[8 * q + 7] = __uint_as_float(kw[q].w & 0xffff0000u); }
#pragma unroll
            for (int i = 0; i < 32; ++i) ss += y[i] * y[i];
            ss += __shfl_xor(ss, 1);
            const float rstd = 1.0f / sqrtf(ss * (1.0f / 64.0f) + EPS);
#pragma unroll
            for (int q = 0; q < 8; ++q) { const f32x4 g = *(const GAS f32x4*)(kg + lhalf * 32 + 4 * q);
                y[4 * q] *= rstd * g[0]; y[4 * q + 1] *= rstd * g[1]; y[4 * q + 2] *= rstd * g[2]; y[4 * q + 3] *= rstd * g[3]; }
            if (lhalf == 0) {
#pragma unroll
                for (int i = 0; i < 8; ++i) { const float2 cs = rope[kpc * 8 + i]; const float x1 = y[i], x2 = y[8 + i]; y[i] = x1 * cs.x - x2 * cs.y; y[8 + i] = x2 * cs.x + x1 * cs.y; } }
            LAS v4u* kd = (LAS v4u*)(L + AT_K_OFF + lrow * AT_KPITCH + lhalf * 64);
            LAS v4u* vd = (LAS v4u*)(L + AT_V_OFF + lhalf * AT_VBLK + lrow * 64);
#pragma unroll
            for (int q = 0; q < 4; ++q) { v4u o; o.x = cvtpk(y[8 * q], y[8 * q + 1]); o.y = cvtpk(y[8 * q + 2], y[8 * q + 3]); o.z = cvtpk(y[8 * q + 4], y[8 * q + 5]); o.w = cvtpk(y[8 * q + 6], y[8 * q + 7]);
                if (!valid) { o = (v4u){0u, 0u, 0u, 0u}; vw[q] = (v4u){0u, 0u, 0u, 0u}; }
                kd[q] = o; vd[q] = vw[q]; }
        }
        GAS v4u* ymp = (GAS v4u*)(YMN + (size_t)((unit * 8 + w) * 8) * 2048) + lane;
        __syncthreads();
        const int hq = kvh * 8 + w; const float sink = sinks[hq];
        const GAS v4u* qs0 = (const GAS v4u*)(AQ + ((size_t)b * SEQ + q0 + r) * 1024 + hq * 64 + 8 * h);
        v4u qnx[4];
#pragma unroll
        for (int s = 0; s < 4; ++s) qnx[s] = qs0[2 * s];
#pragma unroll 1
        for (int j = 0; j < 4; ++j) {
            const int pos = q0 + 32 * j + r;
            v4u ymw[2][2];
#pragma unroll
            for (int rr = 0; rr < 2; ++rr) { ymw[rr][0] = ymp[(size_t)(2 * j + rr) * 256]; ymw[rr][1] = ymp[(size_t)(2 * j + rr) * 256 + 64]; }
            bf16x8 qf[4];
            {
                v4u qw[4];
#pragma unroll
                for (int s = 0; s < 4; ++s) qw[s] = qnx[s];
                if (j < 3) {
#pragma unroll
                    for (int s = 0; s < 4; ++s) qnx[s] = qs0[(size_t)(j + 1) * 4096 + 2 * s]; }
                float x[32]; float ss = 0.f;
#pragma unroll
                for (int s = 0; s < 4; ++s) {
                    x[8 * s + 0] = __uint_as_float(qw[s].x << 16); x[8 * s + 1] = __uint_as_float(qw[s].x & 0xffff0000u); x[8 * s + 2] = __uint_as_float(qw[s].y << 16); x[8 * s + 3] = __uint_as_float(qw[s].y & 0xffff0000u);
                    x[8 * s + 4] = __uint_as_float(qw[s].z << 16); x[8 * s + 5] = __uint_as_float(qw[s].z & 0xffff0000u); x[8 * s + 6] = __uint_as_float(qw[s].w << 16); x[8 * s + 7] = __uint_as_float(qw[s].w & 0xffff0000u); }
#pragma unroll
                for (int i = 0; i < 32; ++i) ss += x[i] * x[i];
                ss += __shfl_xor(ss, 32);
                const float rstd = 0.125f / sqrtf(ss * (1.0f / 64.0f) + EPS);
#pragma unroll
                for (int s = 0; s < 4; ++s) { const f32x4 g0 = *(const GAS f32x4*)(qg + 16 * s + 8 * h), g1 = *(const GAS f32x4*)(qg + 16 * s + 8 * h + 4);
                    x[8 * s + 0] *= rstd * g0[0]; x[8 * s + 1] *= rstd * g0[1]; x[8 * s + 2] *= rstd * g0[2]; x[8 * s + 3] *= rstd * g0[3];
                    x[8 * s + 4] *= rstd * g1[0]; x[8 * s + 5] *= rstd * g1[1]; x[8 * s + 6] *= rstd * g1[2]; x[8 * s + 7] *= rstd * g1[3]; }
#pragma unroll
                for (int i = 0; i < 8; ++i) { const float2 cs = rope[pos * 8 + i]; const float mine = x[i], other = __shfl_xor(mine, 32);
                    x[i] = (h == 0) ? (mine * cs.x - other * cs.y) : (mine * cs.x + other * cs.y); }
#pragma unroll
                for (int s = 0; s < 4; ++s) { v4u o; o.x = cvtpk(x[8 * s], x[8 * s + 1]); o.y = cvtpk(x[8 * s + 2], x[8 * s + 3]); o.z = cvtpk(x[8 * s + 4], x[8 * s + 5]); o.w = cvtpk(x[8 * s + 6], x[8 * s + 7]);
                    qf[s] = __builtin_bit_cast(bf16x8, o); }
            }
            f32x16 sc[5];
#pragma unroll
            for (int c = 0; c < 5; ++c) {
                f32x16 a = {0.f, 0.f, 0.f, 0.f, 0.f, 0.f, 0.f, 0.f, 0.f, 0.f, 0.f, 0.f, 0.f, 0.f, 0.f, 0.f};
                const LAS unsigned char* kp = L + AT_K_OFF + (32 * (j + c) + r) * AT_KPITCH + 16 * h;
                bf16x8 kf[4];
#pragma unroll
                for (int s = 0; s < 4; ++s) kf[s] = *(const LAS bf16x8*)(kp + 32 * s);
                __builtin_amdgcn_sched_barrier(0);
#pragma unroll
                for (int s = 0; s < 4; ++s) a = __builtin_amdgcn_mfma_f32_32x32x16_bf16(kf[s], qf[s], a, 0, 0, 0);
                sc[c] = a;
            }
            const float NEG = -INFINITY;
#pragma unroll
            for (int i = 0; i < 16; ++i) { const int kk = crow(i, h); if (!(kk > r)) sc[0][i] = NEG; if (!(kk <= r)) sc[4][i] = NEG; }
            if (qblk == 0) {
#pragma unroll
                for (int c = 0; c < 4; ++c) { if (32 * (j + c) < 128) {
#pragma unroll
                    for (int i = 0; i < 16; ++i) sc[c][i] = NEG; } } }
            float mx = sink;
#pragma unroll
            for (int c = 0; c < 5; ++c)
#pragma unroll
                for (int i = 0; i < 16; ++i) mx = fmaxf(mx, sc[c][i]);
            mx = fmaxf(mx, __shfl_xor(mx, 32));
            float l = 0.f;
#pragma unroll
            for (int c = 0; c < 5; ++c)
#pragma unroll
                for (int i = 0; i < 16; ++i) { const float p = __expf(sc[c][i] - mx); sc[c][i] = p; l += p; }
            l += __shfl_xor(l, 32);
            l += __expf(sink - mx);
            const float linv = 1.0f / l;
            f32x16 o0 = {0.f, 0.f, 0.f, 0.f, 0.f, 0.f, 0.f, 0.f, 0.f, 0.f, 0.f, 0.f, 0.f, 0.f, 0.f, 0.f}, o1 = o0;
            const int vlane = (4 * h + ((lane & 15) >> 2)) * 64 + (((lane >> 4) & 1) * 16 + 4 * (lane & 3)) * 2;
#pragma unroll
            for (int c = 0; c < 5; ++c) {
                bf16x8 v0[2], v1[2];
#pragma unroll
                for (int s = 0; s < 2; ++s) { const LAS unsigned char* vp = L + AT_V_OFF + (32 * (j + c) + 16 * s) * 64 + vlane;
                    v0[s] = tr_pair(vp, 512); v1[s] = tr_pair(vp + AT_VBLK, 512); }
                __builtin_amdgcn_sched_barrier(0);
#pragma unroll
                for (int s = 0; s < 2; ++s) {
                    v4u pw; pw.x = cvtpk(sc[c][8 * s] * linv, sc[c][8 * s + 1] * linv); pw.y = cvtpk(sc[c][8 * s + 2] * linv, sc[c][8 * s + 3] * linv);
                    pw.z = cvtpk(sc[c][8 * s + 4] * linv, sc[c][8 * s + 5] * linv); pw.w = cvtpk(sc[c][8 * s + 6] * linv, sc[c][8 * s + 7] * linv);
                    const bf16x8 pa = __builtin_bit_cast(bf16x8, pw);
                    o0 = __builtin_amdgcn_mfma_f32_32x32x16_bf16(pa, v0[s], o0, 0, 0, 0);
                    o1 = __builtin_amdgcn_mfma_f32_32x32x16_bf16(pa, v1[s], o1, 0, 0, 0);
                }
            }
            {
                LAS unsigned char* ost = L + AT_OST_OFF + w * 4096;
#pragma unroll
                for (int i = 0; i < 16; ++i) { const int qq = crow(i, h);
                    *(LAS unsigned short*)(ost + qq * 128 + 2 * r) = (unsigned short)f2bf(o0[i]); *(LAS unsigned short*)(ost + qq * 128 + 64 + 2 * r) = (unsigned short)f2bf(o1[i]); }
                bf16* yo = YA + ((size_t)b * SEQ + q0 + 32 * j) * 2048 + hq * 64;
#pragma unroll
                for (int q4 = 0; q4 < 4; ++q4) { const int row = 8 * q4 + (lane >> 3), ch = lane & 7;
                    *(GAS v4u*)(yo + (size_t)row * 2048 + 8 * ch) = *(const LAS v4u*)(ost + row * 128 + 16 * ch); }
            }
#pragma unroll
            for (int rr = 0; rr < 2; ++rr) {
#pragma unroll
                for (int j2 = 0; j2 < 2; ++j2) { float f[8]; unpack8(ymw[rr][j2], f); float ss = 0.f;
#pragma unroll
                    for (int i = 0; i < 8; ++i) ss += f[i] * f[i];
#pragma unroll
                    for (int o = 1; o < 32; o <<= 1) ss += __shfl_xor(ss, o);
                    const float rstd = 1.0f / sqrtf(ss * (1.0f / 256.0f) + EPS);
                    v4u o4; o4.x = cvtpk(f[0] * rstd, f[1] * rstd); o4.y = cvtpk(f[2] * rstd, f[3] * rstd); o4.z = cvtpk(f[4] * rstd, f[5] * rstd); o4.w = cvtpk(f[6] * rstd, f[7] * rstd);
                    ymp[(size_t)(2 * j + rr) * 256 + 64 * j2] = o4; } }
        }
        __syncthreads();
    }
}


__device__ __forceinline__ void conv_phase(Frame& F, const bf16* MQK, const float* cw, const float* cb, bf16* QKC) {
    const int gw = F.vcu * NWAVES + F.wave, NGW = F.G * NWAVES;
    constexpr int NITEM = NB * (SEQ / 32) * 4;
    for (int it = gw; it < NITEM; it += NGW) {
        const int cblk = it & 3, tb = (it >> 2) & (SEQ / 32 - 1), b = it >> 9;
        const int c0 = cblk * 512 + F.lane * 8;
        float w0[8], w1[8], w2[8], w3[8], bb[8];
#pragma unroll
        for (int q = 0; q < 2; ++q) { const f32x4 a0 = *(const GAS f32x4*)(cw + c0 + 4 * q), a1 = *(const GAS f32x4*)(cw + 2048 + c0 + 4 * q), a2 = *(const GAS f32x4*)(cw + 4096 + c0 + 4 * q), a3 = *(const GAS f32x4*)(cw + 6144 + c0 + 4 * q), a4 = *(const GAS f32x4*)(cb + c0 + 4 * q);
#pragma unroll
            for (int i = 0; i < 4; ++i) { w0[4 * q + i] = a0[i]; w1[4 * q + i] = a1[i]; w2[4 * q + i] = a2[i]; w3[4 * q + i] = a3[i]; bb[4 * q + i] = a4[i]; } }
        const float osc = (c0 >= 1024) ? 0.0625f : 1.0f;
        const size_t row0 = (size_t)b * SEQ + tb * 32;
        const GAS v4u* src = (const GAS v4u*)(MQK + row0 * 2048 + c0);
        GAS v4u* dst = (GAS v4u*)(QKC + row0 * 2048 + c0);
        float x0[8], x1[8], x2[8];
        if (tb == 0) {
#pragma unroll
            for (int i = 0; i < 8; ++i) { x0[i] = 0.f; x1[i] = 0.f; x2[i] = 0.f; }
        } else { unpack8(*(src - 3 * 256), x0); unpack8(*(src - 2 * 256), x1); unpack8(*(src - 1 * 256), x2); }
        v4u raw[8], nxt[8];
#pragma unroll
        for (int rr = 0; rr < 8; ++rr) raw[rr] = src[(size_t)rr * 256];
#pragma unroll
        for (int g8 = 0; g8 < 4; ++g8) {
            if (g8 < 3) {
#pragma unroll
                for (int rr = 0; rr < 8; ++rr) nxt[rr] = src[(size_t)(g8 * 8 + 8 + rr) * 256]; }
#pragma unroll
            for (int rr = 0; rr < 8; ++rr) { float x3[8], y[8]; unpack8(raw[rr], x3);
#pragma unroll
                for (int i = 0; i < 8; ++i) { const float v = bb[i] + w0[i] * x0[i] + w1[i] * x1[i] + w2[i] * x2[i] + w3[i] * x3[i];
                    y[i] = osc * v * __builtin_amdgcn_rcpf(1.0f + __expf(-v)); x0[i] = x1[i]; x1[i] = x2[i]; x2[i] = x3[i]; }
                v4u o; o.x = cvtpk(y[0], y[1]); o.y = cvtpk(y[2], y[3]); o.z = cvtpk(y[4], y[5]); o.w = cvtpk(y[6], y[7]);
                dst[(size_t)(g8 * 8 + rr) * 256] = o; }
            if (g8 < 3) {
#pragma unroll
                for (int rr = 0; rr < 8; ++rr) raw[rr] = nxt[rr]; }
        }
    }
}

constexpr int ML_QP = 528, ML_VP = 144;
constexpr int ML_QS = 0, ML_KS = 64 * ML_QP, ML_VT = ML_KS + 80 * ML_QP, ML_VWT = ML_VT + 80 * ML_VP, ML_SS = ML_VWT + 80 * ML_VP, ML_RED = ML_SS + 64 * ML_VP, ML_TAB = ML_RED + 16384, ML_END = ML_TAB + 2 * 2048;
static_assert(ML_END <= RING_BYTES, "mLSTM LDS");
constexpr int ML_OG = XTRA_OFF, ML_OT = XTRA_OFF + 2 * 64 * ML_VP;
static_assert(ML_OT + 64 * ML_VP <= LDS_BYTES, "mLSTM extra LDS");
constexpr int T_G = 0, T_MU = 256, T_ISC = 512, T_FLO = 768, T_QN = 1024, T_DP = 1280;
typedef float f32x4v __attribute__((ext_vector_type(4)));
typedef unsigned u32x2v __attribute__((ext_vector_type(2)));
#define MFMA16(a, b, c) __builtin_amdgcn_mfma_f32_16x16x32_bf16((a), (b), (c), 0, 0, 0)

template <int CTRL> __device__ __forceinline__ float dpp_shr(float src, float ident) {
    return __int_as_float(__builtin_amdgcn_update_dpp(__float_as_int(ident), __float_as_int(src), CTRL, 0xf, 0xf, false)); }
__device__ __forceinline__ float wave_scan_sum(float x, int lane) {
    x += dpp_shr<0x111>(x, 0.f); x += dpp_shr<0x112>(x, 0.f); x += dpp_shr<0x114>(x, 0.f); x += dpp_shr<0x118>(x, 0.f);
    const float t15 = __int_as_float(__builtin_amdgcn_readlane(__float_as_int(x), 15)), t47 = __int_as_float(__builtin_amdgcn_readlane(__float_as_int(x), 47));
    const int row = lane >> 4; x += (row == 1) ? t15 : ((row == 3) ? t47 : 0.f);
    const float t31 = __int_as_float(__builtin_amdgcn_readlane(__float_as_int(x), 31)); x += (row >= 2) ? t31 : 0.f;
    return x; }
__device__ __forceinline__ float wave_scan_max(float x, int lane) {
    const float NI = -INFINITY;
    x = fmaxf(x, dpp_shr<0x111>(x, NI)); x = fmaxf(x, dpp_shr<0x112>(x, NI)); x = fmaxf(x, dpp_shr<0x114>(x, NI)); x = fmaxf(x, dpp_shr<0x118>(x, NI));
    const float t15 = __int_as_float(__builtin_amdgcn_readlane(__float_as_int(x), 15)), t47 = __int_as_float(__builtin_amdgcn_readlane(__float_as_int(x), 47));
    const int row = lane >> 4; x = fmaxf(x, (row == 1) ? t15 : ((row == 3) ? t47 : NI));
    const float t31 = __int_as_float(__builtin_amdgcn_readlane(__float_as_int(x), 31)); x = fmaxf(x, (row >= 2) ? t31 : NI);
    return x; }

__device__ __forceinline__ void mlstm_phase(Frame& F, const bf16* QKC, const bf16* MVO, const float* gates, bf16* HM) {
    LAS unsigned char* L = F.lds + RING_OFF;
    const int tid = F.tid, lane = F.lane, w = F.wave, l15 = lane & 15, kg = lane >> 4, e16 = w & 3, hf = w >> 2;
    const f32x4v Z4 = {0.f, 0.f, 0.f, 0.f};
    const int bt = w & 3;
    const int qtt = (hf == 1 && bt == 0) ? 3 : bt;
    const int tA = (hf == 0) ? 0 : ((bt < 2) ? 4 : 2);
    const int tB = (hf == 0) ? ((bt == 0) ? 4 : 1) : ((bt < 2) ? -1 : ((bt == 2) ? 4 : 3));
    for (int unit = F.vcu; unit < NB * 4 * 4; unit += F.G) {
        const int es = unit & 3, h = (unit >> 2) & 3, b = unit >> 4;
        for (int i = tid; i < 16 * ML_QP / 4; i += NWAVES * 64) ((LAS unsigned*)(L + ML_KS + 64 * ML_QP))[i] = 0u;
        for (int i = tid; i < 16 * ML_VP / 4; i += NWAVES * 64) { ((LAS unsigned*)(L + ML_VT + 64 * ML_VP))[i] = (i < ML_VP / 4) ? 0x3f803f80u : 0u; ((LAS unsigned*)(L + ML_VWT + 64 * ML_VP))[i] = 0u; }
        for (int i = tid; i < 64 * ML_VP / 4; i += NWAVES * 64) ((LAS unsigned*)(L + ML_SS))[i] = 0u;
        f32x4v Cacc[8], nacc[2];
#pragma unroll
        for (int i = 0; i < 8; ++i) Cacc[i] = Z4;
        nacc[0] = Z4; nacc[1] = Z4;
        float m_run = 0.f;
        const int prow = tid >> 3, pseg = tid & 7, vs_ = tid & 63, veg = tid >> 6;
        const size_t seq0 = (size_t)b * SEQ;
        const bf16* qsrc = QKC + (seq0 + prow) * 2048 + h * 256 + pseg * 8;
        const bf16* vsrc = MVO + (seq0 + vs_) * 2048 + h * 256 + es * 64 + veg * 8;
        const bf16* osrc = MVO + (seq0 + prow) * 2048 + 1024 + h * 256 + es * 64 + pseg * 8;
        bf16* odst = HM + (seq0 + prow) * 2048 + h * 256 + es * 64 + pseg * 8;
        const float* gsrc = gates + (seq0 + lane) * 8 + h;
        v4u pq[4], pk[4], pv, po; float pgi, pgf;
#define ML_PREFETCH(c) do { const size_t ro = (size_t)(c) * 64 * 2048; \
            _Pragma("unroll") for (int i = 0; i < 4; ++i) { pq[i] = *(const GAS v4u*)(qsrc + ro + 64 * i); pk[i] = *(const GAS v4u*)(qsrc + ro + 1024 + 64 * i); } \
            pv = *(const GAS v4u*)(vsrc + ro); \
            po = *(const GAS v4u*)(osrc + ro); \
            pgi = gsrc[(size_t)(c) * 64 * 8]; pgf = gsrc[(size_t)(c) * 64 * 8 + 4]; } while (0)
        ML_PREFETCH(0);
        __syncthreads();
#pragma unroll 1
        for (int c = 0; c < SEQ / 64; ++c) {
            LAS unsigned char* TB = L + ML_TAB + (c & 1) * 2048;
            const float bsum = wave_scan_sum(pgf, lane);
            const float gg = pgi - bsum;
            const float mxs = wave_scan_max(gg, lane);
            const float mu = fmaxf(m_run, mxs), isc = __expf(m_run - mu), flo = __expf(-(bsum + mu));
            const float mu63 = __int_as_float(__builtin_amdgcn_readlane(__float_as_int(mu), 63)), b63 = __int_as_float(__builtin_amdgcn_readlane(__float_as_int(bsum), 63));
            const float wgt = __expf(gg - mu63), decay = __expf(m_run - mu63);
            m_run = b63 + mu63;
            if (w == 0) { *(LAS float*)(TB + T_G + 4 * lane) = gg; *(LAS float*)(TB + T_MU + 4 * lane) = mu; *(LAS float*)(TB + T_ISC + 4 * lane) = isc; *(LAS float*)(TB + T_FLO + 4 * lane) = flo;
                *(LAS unsigned short*)(L + ML_VWT + 64 * ML_VP + 2 * lane) = (unsigned short)f2bf(wgt); }
#pragma unroll
            for (int i = 0; i < 4; ++i) { *(LAS v4u*)(L + ML_QS + prow * ML_QP + pseg * 16 + 128 * i) = pq[i]; *(LAS v4u*)(L + ML_KS + prow * ML_QP + pseg * 16 + 128 * i) = pk[i]; }
            { float vf[8]; unpack8(pv, vf);
              const unsigned vr[4] = {pv.x, pv.y, pv.z, pv.w};
#pragma unroll
              for (int i = 0; i < 8; ++i) { *(LAS unsigned short*)(L + ML_VT + (8 * veg + i) * ML_VP + 2 * vs_) = (unsigned short)((i & 1) ? (vr[i >> 1] >> 16) : (vr[i >> 1] & 0xffffu));
                  *(LAS unsigned short*)(L + ML_VWT + (8 * veg + i) * ML_VP + 2 * vs_) = (unsigned short)f2bf(wgt * vf[i]); } }
            *(LAS v4u*)(L + ML_OG + (c & 1) * 64 * ML_VP + prow * ML_VP + pseg * 16) = po;
            if (c + 1 < SEQ / 64) ML_PREFETCH(c + 1);
            __syncthreads();
            if (c > 0) *(GAS v4u*)(odst + (size_t)(c - 1) * 64 * 2048) = *(const LAS v4u*)(L + ML_OT + prow * ML_VP + pseg * 16);
            bf16x8 bc[4];
#pragma unroll
            for (int ks = 0; ks < 4; ++ks) { v4u p; p.x = cvtpk(Cacc[2 * ks][0], Cacc[2 * ks][1]); p.y = cvtpk(Cacc[2 * ks][2], Cacc[2 * ks][3]); p.z = cvtpk(Cacc[2 * ks + 1][0], Cacc[2 * ks + 1][1]); p.w = cvtpk(Cacc[2 * ks + 1][2], Cacc[2 * ks + 1][3]);
                bc[ks] = __builtin_bit_cast(bf16x8, p); }
            {
                bf16x8 vwb[2], vwn[2];
#pragma unroll
                for (int ks = 0; ks < 2; ++ks) { vwb[ks] = *(const LAS bf16x8*)(L + ML_VWT + (16 * e16 + l15) * ML_VP + 64 * ks + 16 * kg); vwn[ks] = *(const LAS bf16x8*)(L + ML_VWT + (64 + l15) * ML_VP + 64 * ks + 16 * kg); }
                nacc[0] = nacc[0] * decay; nacc[1] = nacc[1] * decay;
#pragma unroll
                for (int dh = 0; dh < 2; ++dh) {
                    bf16x8 ka[4][2];
#pragma unroll
                    for (int d4 = 0; d4 < 4; ++d4)
#pragma unroll
                        for (int ks = 0; ks < 2; ++ks) ka[d4][ks] = tr_pair(L + ML_KS + (32 * ks + 8 * kg + (l15 >> 2)) * ML_QP + 2 * (128 * hf + 16 * (4 * dh + d4) + 4 * (lane & 3)), 4 * ML_QP);
                    __builtin_amdgcn_sched_barrier(0);
#pragma unroll
                    for (int d4 = 0; d4 < 4; ++d4) { const int dt = 4 * dh + d4;
                        Cacc[dt] = Cacc[dt] * decay;
#pragma unroll
                        for (int ks = 0; ks < 2; ++ks) { Cacc[dt] = MFMA16(ka[d4][ks], vwb[ks], Cacc[dt]);
                            if ((dt >> 1) == e16) nacc[dt & 1] = MFMA16(ka[d4][ks], vwn[ks], nacc[dt & 1]); } }
                }
            }
            {
                bf16x8 qfr[8];
#pragma unroll
                for (int ks = 0; ks < 8; ++ks) qfr[ks] = *(const LAS bf16x8*)(L + ML_QS + (16 * qtt + l15) * ML_QP + 64 * ks + 16 * kg);
                const int tq = 16 * qtt + l15; const float mu_t = *(const LAS float*)(TB + T_MU + 4 * tq);
                __builtin_amdgcn_sched_barrier(0);
#pragma unroll
                for (int si = 0; si < 2; ++si) {
                    const int st = si ? tB : tA; if (st < 0) break;
                    bf16x8 kf[8];
#pragma unroll
                    for (int ks = 0; ks < 8; ++ks) kf[ks] = *(const LAS bf16x8*)(L + ML_KS + (16 * st + l15) * ML_QP + 64 * ks + 16 * kg);
                    __builtin_amdgcn_sched_barrier(0);
                    f32x4v a = Z4;
#pragma unroll
                    for (int ks = 0; ks < 8; ++ks) a = MFMA16(kf[ks], qfr[ks], a);
                    __builtin_amdgcn_sched_barrier(0);
                    if (st < 4) {
                        const f32x4v g4 = *(const LAS f32x4v*)(TB + T_G + 4 * (16 * st + 4 * kg));
                        float sv[4];
#pragma unroll
                        for (int i = 0; i < 4; ++i) { const int s_ = 16 * st + 4 * kg + i; const float dd = __expf(g4[i] - mu_t); sv[i] = (s_ <= tq) ? a[i] * dd : 0.f; }
                        u32x2v pk2v; pk2v.x = cvtpk(sv[0], sv[1]); pk2v.y = cvtpk(sv[2], sv[3]);
                        *(LAS u32x2v*)(L + ML_SS + tq * ML_VP + 2 * (16 * st + 4 * kg)) = pk2v;
                    } else { if (kg == 0) *(LAS float*)(TB + T_QN + 4 * tq) = a[0]; }
                }
            }
            __syncthreads();
            f32x4v val[4], accD = Z4;
            {
                const bf16x8 vb = *(const LAS bf16x8*)(L + ML_VT + (16 * e16 + l15) * ML_VP + 64 * hf + 16 * kg);
                const bf16x8 vd = *(const LAS bf16x8*)(L + ML_VT + (64 + l15) * ML_VP + 64 * hf + 16 * kg);
                bf16x8 sa[4];
#pragma unroll
                for (int tt = 0; tt < 4; ++tt) sa[tt] = *(const LAS bf16x8*)(L + ML_SS + (16 * tt + l15) * ML_VP + 64 * hf + 16 * kg);
                __builtin_amdgcn_sched_barrier(0);
#pragma unroll
                for (int tt = 0; tt < 4; ++tt) {
                    u32x2v qlo[4], qhi[4];
#pragma unroll
                    for (int ks = 0; ks < 4; ++ks) { const LAS unsigned char* qp = L + ML_QS + (16 * tt + l15) * ML_QP + 2 * (128 * hf + 32 * ks + 4 * kg); qlo[ks] = *(const LAS u32x2v*)qp; qhi[ks] = *(const LAS u32x2v*)(qp + 32); }
                    __builtin_amdgcn_sched_barrier(0);
                    f32x4v aB = Z4;
#pragma unroll
                    for (int ks = 0; ks < 4; ++ks) { const v4u qa = {qlo[ks].x, qlo[ks].y, qhi[ks].x, qhi[ks].y}; aB = MFMA16(__builtin_bit_cast(bf16x8, qa), bc[ks], aB); }
                    f32x4v aA = Z4;
                    if (hf == 0 || tt >= 2) { aA = MFMA16(sa[tt], vb, Z4); if (tt == e16) accD = MFMA16(sa[tt], vd, Z4); }
                    const f32x4v i4 = *(const LAS f32x4v*)(TB + T_ISC + 4 * (16 * tt + 4 * kg));
                    val[tt] = aA + i4 * aB;
                }
                const f32x4v s0 = hf ? val[0] : val[2], s1 = hf ? val[1] : val[3];
                *(LAS f32x4v*)(L + ML_RED + ((w * 2 + 0) * 64 + lane) * 16) = s0; *(LAS f32x4v*)(L + ML_RED + ((w * 2 + 1) * 64 + lane) * 16) = s1;
                if (l15 == 0) *(LAS f32x4v*)(TB + T_DP + 4 * (hf * 64 + 16 * e16 + 4 * kg)) = accD;
            }
            __syncthreads();
            if (l15 == 0) {
#pragma unroll
                for (int q2 = 0; q2 < 2; ++q2)
#pragma unroll
                    for (int i = 0; i < 4; ++i) *(LAS unsigned short*)(L + ML_KS + 64 * ML_QP + 2 * (128 * hf + 16 * (2 * e16 + q2) + 4 * kg + i)) = (unsigned short)f2bf(nacc[q2][i]);
            }
            {
                const f32x4v k0 = hf ? val[2] : val[0], k1 = hf ? val[3] : val[1];
                const f32x4v r0 = *(const LAS f32x4v*)(L + ML_RED + (((w ^ 4) * 2 + 0) * 64 + lane) * 16), r1 = *(const LAS f32x4v*)(L + ML_RED + (((w ^ 4) * 2 + 1) * 64 + lane) * 16);
                const f32x4v num[2] = {k0 + r0, k1 + r1};
#pragma unroll
                for (int q2 = 0; q2 < 2; ++q2) { const int t4 = 16 * (2 * hf + q2) + 4 * kg;
                    const f32x4v d0 = *(const LAS f32x4v*)(TB + T_DP + 4 * t4), d1 = *(const LAS f32x4v*)(TB + T_DP + 4 * (64 + t4)), i4 = *(const LAS f32x4v*)(TB + T_ISC + 4 * t4), q4 = *(const LAS f32x4v*)(TB + T_QN + 4 * t4), f4 = *(const LAS f32x4v*)(TB + T_FLO + 4 * t4);
#pragma unroll
                    for (int i = 0; i < 4; ++i) { const float den = d0[i] + d1[i] + i4[i] * q4[i]; const float hv = num[q2][i] * __builtin_amdgcn_rcpf(fmaxf(fabsf(den), f4[i]));
                        const float o = __uint_as_float(((unsigned)*(const LAS unsigned short*)(L + ML_OG + (c & 1) * 64 * ML_VP + (t4 + i) * ML_VP + 2 * (16 * e16 + l15))) << 16);
                        *(LAS unsigned short*)(L + ML_OT + (t4 + i) * ML_VP + 2 * (16 * e16 + l15)) = (unsigned short)f2bf(hv * __builtin_amdgcn_rcpf(1.0f + __expf(-o))); } }
            }
        }
#undef ML_PREFETCH
        __syncthreads();
        *(GAS v4u*)(odst + (size_t)(SEQ / 64 - 1) * 64 * 2048) = *(const LAS v4u*)(L + ML_OT + prow * ML_VP + pseg * 16);
        __syncthreads();
    }
}

__global__ void __launch_bounds__(NWAVES * 64, 2) fwd(Args args) {
    __shared__ __attribute__((aligned(16))) unsigned char lds[LDS_BYTES];
    Frame F;
    F.lds = (LAS unsigned char*)lds;
    F.MISC = (volatile LAS unsigned*)(F.lds + MISC_OFF);
    F.tid = threadIdx.x; F.lane = F.tid & 63; F.wave = __builtin_amdgcn_readfirstlane(F.tid >> 6);
    F.G = gridDim.x; { const int bx = blockIdx.x; F.vcu = (F.G % 8 == 0) ? (bx % 8) * (F.G / 8) + bx / 8 : bx; }
    unsigned char* ws = args.ws;
    F.ctl = (gu32*)(ws + WS_CTL);
    for (int u = F.tid; u < LDSCTL_BYTES / 4; u += NWAVES * 64) ((LAS unsigned*)(F.lds + LDSCTL_OFF))[u] = 0u;
    __syncthreads();
    const int lo = args.ph_lo, hi = args.ph_hi;
    XcdBarrier bar; bar.bar = (unsigned*)(F.ctl + CW_BAR) + args.li * XCD_BAR_WORDS; bar.x = 0; bar.st = nullptr;
    if (hi - lo > 1) bar = xcd_barrier_post((unsigned*)(F.ctl + CW_BAR) + args.li * XCD_BAR_WORDS, F.MISC + 8);
#define IN(k) (lo <= (k) && (k) < hi)
#define BOTH(k) (IN(k) && IN((k) + 1))
#define GRID_BAR() xcd_barrier(bar)
    bf16* H1 = (bf16*)args.out; bf16* QKC = (bf16*)args.out; bf16* CAT = (bf16*)(ws + WS_CAT);
    bf16* MQK = (bf16*)(ws + WS_MQK); bf16* MVO = (bf16*)(ws + WS_MVO); bf16* AQ = (bf16*)(ws + WS_AQ); bf16* AKV = (bf16*)(ws + WS_AKV); bf16* GMA = (bf16*)(ws + WS_GMA);
    bf16* TB = (bf16*)(ws + WS_T); bf16* X1B = (bf16*)(ws + WS_X1B); bf16* ACT = (bf16*)(ws + WS_ACT); float* SSQ2 = (float*)(ws + WS_SSQ2);

    if (IN(0)) { p0_prologue(F, args); if (BOTH(0)) GRID_BAR(); }
    if (IN(1)) {
        pg8::Gemm g{H1, (const bf16*)(ws + WS_W1T), M, NPROJ, D, D, D}; pg8::StaticOrder S; S.init(M, NPROJ, F.G, (int)blockIdx.x);
        pg8::EpiProj E{MQK, MVO, AQ, AKV, GMA, args.in[10]};
        pg8::gemm_phase<pg8::EpiProj, pg8::StaticOrder, PG8_ALIGN, PG8_SP2>(F.lds + RING_OFF, g, S, E);
        if (BOTH(1)) GRID_BAR();
    }
    if (IN(2)) { conv_phase(F, MQK, args.in[3], args.in[4], QKC); if (BOTH(2)) GRID_BAR(); }
    if (IN(3)) { mlstm_phase(F, QKC, MVO, (const float*)(ws + WS_GATES), CAT + 1024); if (BOTH(3)) GRID_BAR(); }
    if (IN(4)) {
        attn_phase(F, AQ, AKV, args.in[7], args.in[8], args.in[9], (const float2*)(ws + WS_ROPE), CAT, CAT + 1024);
        if (BOTH(4)) GRID_BAR(); }
    if (IN(5)) {
        pg8::Gemm g{CAT, (const bf16*)(ws + WS_WCAT), M, D, 2 * D, 2 * D, 2 * D}; pg8::StaticOrder S; S.init(M, D, F.G, (int)blockIdx.x);
        pg8::EpiGate2 E{TB, GMA};
        pg8::gemm_phase<pg8::EpiGate2, pg8::StaticOrder, PG8_ALIGN, PG8_SP2>(F.lds + RING_OFF, g, S, E);
        if (BOTH(5)) GRID_BAR();
    }
    if (IN(6)) {
        pg8::Gemm g{TB, (const bf16*)(ws + WS_WOUT), M, D, D, D, D}; pg8::PanelOrder S; S.init(M, D, F.G, (int)blockIdx.x);
        pg8::EpiX1 E{args.in[0], X1B, SSQ2, {}};
        pg8::gemm_phase<pg8::EpiX1, pg8::PanelOrder, PG8_ALIGN, PG8_SP2>(F.lds + RING_OFF, g, S, E);
        if (BOTH(6)) GRID_BAR();
    }
    if (IN(7)) {
        pg8::Gemm g{X1B, (const bf16*)(ws + WS_WFI), M, NFF2, D, D, D}; pg8::StaticOrder S; S.init(M, NFF2, F.G, (int)blockIdx.x);
        pg8::EpiSwiGLU E{SSQ2, ACT, EPS};
        pg8::gemm_phase<pg8::EpiSwiGLU, pg8::StaticOrder, PG8_ALIGN, PG8_SP2>(F.lds + RING_OFF, g, S, E);
        if (BOTH(7)) GRID_BAR();
    }
    if (IN(8)) {
        pg8::Gemm g{ACT, (const bf16*)(ws + WS_WFO), M, D, DFF, DFF, DFF}; pg8::StaticOrder S; S.init(M, D, F.G, (int)blockIdx.x);
        pg8::EpiOut E{X1B, args.out};
        pg8::gemm_phase<pg8::EpiOut, pg8::StaticOrder, PG8_ALIGN, PG8_SP2>(F.lds + RING_OFF, g, S, E);
    }
#undef IN
#undef BOTH
#undef GRID_BAR
}

extern "C" void kernel_launch(void* const* d_in, const int* in_sizes, int n_in, void* d_out, int out_size, void* d_ws, size_t ws_size, hipStream_t stream) {
    static int grid = 0;
    if (grid == 0) {
        if (n_in != 17 || in_sizes[0] != M * D || out_size != M * D || ws_size < WS_END) { fprintf(stderr, "kernel_launch: unexpected shapes / workspace (n_in %d, in0 %d, out %d, ws %zu)\n", n_in, n_in > 0 ? in_sizes[0] : -1, out_size, ws_size); grid = -1; return; }
        int dev = 0, cus = 0;
        if (hipGetDevice(&dev) != hipSuccess || hipDeviceGetAttribute(&cus, hipDeviceAttributeMultiprocessorCount, dev) != hipSuccess) { grid = -1; return; }
        grid = cus;
    }
    if (grid < 0) return;
    (void)hipMemsetAsync((char*)d_ws + WS_CTL, 0, CTL_ZERO_BYTES, stream);
    Args a{};
    for (int i = 0; i < 17; ++i) a.in[i] = (const float*)d_in[i];
    a.out = (float*)d_out; a.ws = (unsigned char*)d_ws;
    unsigned char* ws = (unsigned char*)d_ws;
    int nl = 0;
    auto run = [&](int lo, int hi) { a.ph_lo = lo; a.ph_hi = hi; a.li = nl++; hipLaunchKernelGGL(fwd, dim3(grid), dim3(NWAVES * 64), 0, stream, a); };
    run(0, 9);
}
```

```cpp
#include <hip/hip_runtime.h>
#include <cstdio>
#include <cstdint>
namespace pg8 {
#define PG8_LAS __attribute__((address_space(3)))
typedef unsigned short bf16_t;
typedef short bf16x8 __attribute__((ext_vector_type(8)));
typedef float f32x4 __attribute__((ext_vector_type(4)));
typedef unsigned u32x4 __attribute__((ext_vector_type(4)));
constexpr int BM = 256, BK = 64, HALF = 128, HTB = HALF * BK * 2  , STAGE_BYTES = 8 * HTB, NXCD = 8, WGM = 4;

__host__ __device__ __forceinline__ int lds_byte(int r, int c) { const int st = (r >> 4) * 2 + (c >> 5), rr = r & 15, cc = c & 31, ob = rr * 64 + cc * 2; return st * 1024 + (ob ^ (((ob >> 9) & 1) << 5)); }
__host__ __device__ __forceinline__ void stage_rc(int b, int& R, int& C) { const int st = b / 1024, sb = b % 1024, swz = sb ^ (((sb >> 9) & 1) << 5); R = (st >> 1) * 16 + swz / 64; C = (st & 1) * 32 + (swz % 64) / 2; }
__host__ __device__ __forceinline__ int perm32(int rho) { const int n = rho >> 4, i = rho & 15; return 8 * (i >> 2) + 4 * n + (i & 3); }

struct Unit { int pm, pn; };
struct Gemm { const bf16_t* A; const bf16_t* Bt; int M, N, K, lda, ldb; };

struct StaticOrder {
    int nM, nN, nwg, G, c;
    __host__ __device__ void init(int M, int N, int G_, int c_) { nM = M / BM; nN = N / BM; nwg = nM * nN; G = G_; c = c_; }
    __host__ __device__ bool next(int i, Unit& u) const {
        const long L = (long)i * G + c; if (L >= nwg) return false;
        int wgid = (int)L; { const int q = nwg / NXCD, r = nwg % NXCD, xcd = wgid % NXCD, off = wgid / NXCD; wgid = (xcd < r ? xcd * (q + 1) : r * (q + 1) + (xcd - r) * q) + off; }
        const int nig = WGM * nN, gid = wgid / nig, fm = gid * WGM, gsz = (nM - fm) < WGM ? (nM - fm) : WGM;
        u.pm = fm + ((wgid % nig) % gsz); u.pn = (wgid % nig) / gsz; return true;
    }
    __device__ __forceinline__ void a_ready(const Unit&) const {}
    __device__ __forceinline__ void done(const Unit&) const {}
};
__device__ __forceinline__ unsigned cvt_pk_bf16(float lo, float hi) { unsigned r; asm volatile("v_cvt_pk_bf16_f32 %0, %1, %2" : "=v"(r) : "v"(lo), "v"(hi)); return r; }
typedef float f32x2 __attribute__((ext_vector_type(2)));

__device__ __forceinline__ float bf_lo(unsigned w) { return __uint_as_float(w << 16); }
__device__ __forceinline__ float bf_hi(unsigned w) { return __uint_as_float(w & 0xffff0000u); }
__device__ __forceinline__ float sigmoid_f(float x) { return __builtin_amdgcn_rcpf(1.0f + __expf(-x)); }
__device__ __forceinline__ unsigned cvt_pk_vis(float lo, float hi) { typedef float f2_t __attribute__((ext_vector_type(2))); typedef __bf16 b2_t __attribute__((ext_vector_type(2)));
    f2_t v = {lo, hi}; b2_t b = __builtin_convertvector(v, b2_t); return __builtin_bit_cast(unsigned, b); }

struct EpiProj {
    static constexpr bool PERM = true, AFTER_DRAIN = false, HAS_MID = false;
    bf16_t *mqk, *mvo, *aq, *akv, *gma; const float* bmerge;
    __device__ __forceinline__ void operator()(const f32x4 (&acc)[2][2][4][2], const Unit& u, int wr, int wc, int fr, int fq) const {
        const int pn = u.pn; const int row0 = u.pm * BM + wr * 64 + fr;
        if (pn < 21) {
            bf16_t* base; int ld, colt;
            if (pn < 8) { base = mqk; ld = 2048; colt = pn * 256; }
            else if (pn < 16) { base = mvo; ld = 2048; colt = (pn - 8) * 256; }
            else if (pn < 20) { base = aq; ld = 1024; colt = (pn - 16) * 256; }
            else { base = akv; ld = 256; colt = 0; }
            const int col0 = colt + wc * 32 + 8 * fq;
#pragma unroll
            for (int ai = 0; ai < 2; ++ai)
#pragma unroll
                for (int m = 0; m < 4; ++m) { bf16_t* rowp = base + (size_t)(row0 + ai * HALF + m * 16) * ld + col0;
#pragma unroll
                    for (int bj = 0; bj < 2; ++bj) { const f32x4 v0 = acc[ai][bj][m][0], v1 = acc[ai][bj][m][1];
                        u32x4 w; w.x = cvt_pk_bf16(v0[0], v0[1]); w.y = cvt_pk_bf16(v0[2], v0[3]); w.z = cvt_pk_bf16(v1[0], v1[1]); w.w = cvt_pk_bf16(v1[2], v1[3]);
                        *(u32x4*)(rowp + bj * HALF) = w; } }
        } else {
            const int col0 = (pn - 21) * HALF + wc * 32 + 8 * fq;
            f32x4 bm[2], ba[2];
#pragma unroll
            for (int n = 0; n < 2; ++n) { bm[n] = *(const f32x4*)(bmerge + col0 + 4 * n); ba[n] = *(const f32x4*)(bmerge + 1024 + col0 + 4 * n); }
#pragma unroll
            for (int ai = 0; ai < 2; ++ai)
#pragma unroll
                for (int m = 0; m < 4; ++m) { bf16_t* rowp = gma + (size_t)(row0 + ai * HALF + m * 16) * 2048 + col0;
                    float gs[8], gr[8];
#pragma unroll
                    for (int j = 0; j < 8; ++j) { const float em = __expf(-fminf(fmaxf(acc[ai][0][m][j >> 2][j & 3] + bm[j >> 2][j & 3], -60.0f), 60.0f)), ea = __expf(-fminf(fmaxf(acc[ai][1][m][j >> 2][j & 3] + ba[j >> 2][j & 3], -60.0f), 60.0f));
                        gs[j] = __builtin_amdgcn_rcpf(1.0f + em); gr[j] = (1.0f + em) * __builtin_amdgcn_rcpf(1.0f + ea); }
                    u32x4 w; w.x = cvt_pk_vis(gs[0], gs[1]); w.y = cvt_pk_vis(gs[2], gs[3]); w.z = cvt_pk_vis(gs[4], gs[5]); w.w = cvt_pk_vis(gs[6], gs[7]);
                    *(u32x4*)rowp = w;
                    w.x = cvt_pk_vis(gr[0], gr[1]); w.y = cvt_pk_vis(gr[2], gr[3]); w.z = cvt_pk_vis(gr[4], gr[5]); w.w = cvt_pk_vis(gr[6], gr[7]);
                    *(u32x4*)(rowp + 1024) = w; }
        }
    }
};
struct EpiGate2 {
    static constexpr bool PERM = true, AFTER_DRAIN = false, HAS_MID = true;
    bf16_t* T; const bf16_t* G;
    __device__ __forceinline__ void mid(f32x4 (&acc)[2][2][4][2], const Unit& u, int wr, int wc, int fr, int fq) const {
        const int row0 = u.pm * BM + wr * 64 + fr, col0 = u.pn * BM + wc * 32 + 8 * fq;
        u32x4 gc, gn;
        gc = *(const u32x4*)(G + (size_t)row0 * 2048 + 1024 + col0);
#pragma unroll
        for (int st = 0; st < 16; ++st) { const int bj = st >> 3, gi = st & 7, ai = gi >> 2, m = gi & 3;
            if (st < 15) { const int bjn = (st + 1) >> 3, gin = (st + 1) & 7; gn = *(const u32x4*)(G + (size_t)(row0 + (gin >> 2) * HALF + (gin & 3) * 16) * 2048 + 1024 + col0 + bjn * HALF); }
            acc[ai][bj][m][0][0] *= bf_lo(gc.x); acc[ai][bj][m][0][1] *= bf_hi(gc.x); acc[ai][bj][m][0][2] *= bf_lo(gc.y); acc[ai][bj][m][0][3] *= bf_hi(gc.y);
            acc[ai][bj][m][1][0] *= bf_lo(gc.z); acc[ai][bj][m][1][1] *= bf_hi(gc.z); acc[ai][bj][m][1][2] *= bf_lo(gc.w); acc[ai][bj][m][1][3] *= bf_hi(gc.w);
            if (st < 15) gc = gn; }
    }
    __device__ __forceinline__ void operator()(const f32x4 (&acc)[2][2][4][2], const Unit& u, int wr, int wc, int fr, int fq) const {
        const int row0 = u.pm * BM + wr * 64 + fr, col0 = u.pn * BM + wc * 32 + 8 * fq;
        u32x4 gc, gn;
        gc = *(const u32x4*)(G + (size_t)row0 * 2048 + col0);
#pragma unroll
        for (int st = 0; st < 16; ++st) { const int bj = st >> 3, gi = st & 7, ai = gi >> 2, m = gi & 3;
            if (st < 15) { const int bjn = (st + 1) >> 3, gin = (st + 1) & 7; gn = *(const u32x4*)(G + (size_t)(row0 + (gin >> 2) * HALF + (gin & 3) * 16) * 2048 + col0 + bjn * HALF); }
            const f32x4 v0 = acc[ai][bj][m][0], v1 = acc[ai][bj][m][1];
            u32x4 w; w.x = cvt_pk_bf16(v0[0] * bf_lo(gc.x), v0[1] * bf_hi(gc.x)); w.y = cvt_pk_bf16(v0[2] * bf_lo(gc.y), v0[3] * bf_hi(gc.y));
            w.z = cvt_pk_bf16(v1[0] * bf_lo(gc.z), v1[1] * bf_hi(gc.z)); w.w = cvt_pk_bf16(v1[2] * bf_lo(gc.w), v1[3] * bf_hi(gc.w));
            *(u32x4*)(T + (size_t)(row0 + ai * HALF + m * 16) * 1024 + col0 + bj * HALF) = w;
            if (st < 15) gc = gn; }
    }
};
struct PanelOrder {
    int nM, nN, G, c;
    __host__ __device__ void init(int M, int N, int G_, int c_) { nM = M / BM; nN = N / BM; G = G_; c = c_; }
    __host__ __device__ bool next(int i, Unit& u) const { const int pm = c + (i / nN) * G; if (pm >= nM) return false; u.pm = pm; u.pn = i % nN; return true; }
    __device__ __forceinline__ void a_ready(const Unit&) const {}
    __device__ __forceinline__ void done(const Unit&) const {}
};
struct EpiX1 {
    static constexpr bool PERM = false, AFTER_DRAIN = false, HAS_MID = false;
    const float* x; bf16_t* x1b; float* ssq; PG8_LAS float* red; mutable int par;
    __device__ __forceinline__ void operator()(const f32x4 (&acc)[2][2][4][2], const Unit& u, int wr, int wc, int fr, int fq) const {
        const int row0 = u.pm * BM + wr * 64 + fr, col0 = u.pn * BM + wc * 32 + 4 * fq;
        PG8_LAS float* tab = red + (par & 1) * 1024; par ^= 1;
#pragma unroll
        for (int ai = 0; ai < 2; ++ai) {
            f32x4 xv[4][4];
#pragma unroll
            for (int m = 0; m < 4; ++m)
#pragma unroll
                for (int q = 0; q < 4; ++q) xv[m][q] = *(const f32x4*)(x + (size_t)(row0 + ai * HALF + m * 16) * 1024 + col0 + (q >> 1) * HALF + (q & 1) * 16);
#pragma unroll
            for (int m = 0; m < 4; ++m) { const size_t r = (size_t)(row0 + ai * HALF + m * 16); float s = 0.f;
#pragma unroll
                for (int q = 0; q < 4; ++q) { const size_t o = r * 1024 + col0 + (q >> 1) * HALF + (q & 1) * 16;
                    const f32x4 v = xv[m][q] + acc[ai][q >> 1][m][q & 1];
                    s += (v[0] * v[0] + v[1] * v[1]) + (v[2] * v[2] + v[3] * v[3]);
                    uint2 w; w.x = cvt_pk_bf16(v[0], v[1]); w.y = cvt_pk_bf16(v[2], v[3]); *(uint2*)(x1b + o) = w; }
                s += __shfl_xor(s, 16); s += __shfl_xor(s, 32);
                if (fq == 0) tab[(wr * 4 + wc) * 128 + (ai * 4 + m) * 16 + fr] = s; } }
        asm volatile("s_waitcnt lgkmcnt(0)" ::: "memory");
        __builtin_amdgcn_s_barrier();
        if (wc == 0) {
#pragma unroll
            for (int k = 0; k < 2; ++k) { const int idx = fq * 16 + fr + 64 * k, gi = idx >> 4, f = idx & 15;
                const float s = (tab[(wr * 4 + 0) * 128 + idx] + tab[(wr * 4 + 1) * 128 + idx]) + (tab[(wr * 4 + 2) * 128 + idx] + tab[(wr * 4 + 3) * 128 + idx]);
                ssq[(size_t)(u.pm * BM + wr * 64 + (gi >> 2) * HALF + (gi & 3) * 16 + f) * 4 + u.pn] = s; } }
    }
};
struct EpiSwiGLU {
    static constexpr bool PERM = true, AFTER_DRAIN = false, HAS_MID = false;
    const float* ssq; bf16_t* act; float eps;
    __device__ __forceinline__ void operator()(const f32x4 (&acc)[2][2][4][2], const Unit& u, int wr, int wc, int fr, int fq) const {
        const int row0 = u.pm * BM + wr * 64 + fr, col0 = u.pn * HALF + wc * 32 + 8 * fq;
        float rs[8];
#pragma unroll
        for (int gi = 0; gi < 8; ++gi) { const f32x4 s = *(const f32x4*)(ssq + (size_t)(row0 + (gi >> 2) * HALF + (gi & 3) * 16) * 4);
            rs[gi] = __builtin_amdgcn_rsqf(((s[0] + s[1]) + (s[2] + s[3])) * (1.0f / 1024.0f) + eps); }
#pragma unroll
        for (int gi = 0; gi < 8; ++gi) { const int ai = gi >> 2, m = gi & 3; const size_t r = (size_t)(row0 + ai * HALF + m * 16); const float rstd = rs[gi];
            float a[8];
#pragma unroll
            for (int n = 0; n < 2; ++n)
#pragma unroll
                for (int j = 0; j < 4; ++j) { const float g = rstd * acc[ai][0][m][n][j], up = rstd * acc[ai][1][m][n][j]; a[4 * n + j] = g * sigmoid_f(g) * up; }
            u32x4 w; w.x = cvt_pk_bf16(a[0], a[1]); w.y = cvt_pk_bf16(a[2], a[3]); w.z = cvt_pk_bf16(a[4], a[5]); w.w = cvt_pk_bf16(a[6], a[7]);
            *(u32x4*)(act + r * 2816 + col0) = w; }
    }
};
struct EpiOut {
    static constexpr bool PERM = false, AFTER_DRAIN = false, HAS_MID = false;
    const bf16_t* x1b; float* out;
    __device__ __forceinline__ void operator()(const f32x4 (&acc)[2][2][4][2], const Unit& u, int wr, int wc, int fr, int fq) const {
        const int row0 = u.pm * BM + wr * 64 + fr, col0 = u.pn * BM + wc * 32 + 4 * fq;
#pragma unroll
        for (int ai = 0; ai < 2; ++ai) {
            uint2 xv[4][4];
#pragma unroll
            for (int m = 0; m < 4; ++m)
#pragma unroll
                for (int q = 0; q < 4; ++q) xv[m][q] = *(const uint2*)(x1b + (size_t)(row0 + ai * HALF + m * 16) * 1024 + col0 + (q >> 1) * HALF + (q & 1) * 16);
#pragma unroll
            for (int m = 0; m < 4; ++m) { const size_t r = (size_t)(row0 + ai * HALF + m * 16);
#pragma unroll
                for (int q = 0; q < 4; ++q) { const f32x4 a = acc[ai][q >> 1][m][q & 1]; f32x4 o; o[0] = bf_lo(xv[m][q].x) + a[0]; o[1] = bf_hi(xv[m][q].x) + a[1]; o[2] = bf_lo(xv[m][q].y) + a[2]; o[3] = bf_hi(xv[m][q].y) + a[3];
                    *(f32x4*)(out + r * 1024 + col0 + (q >> 1) * HALF + (q & 1) * 16) = o; } } }
    }
};

template <class Epi, class Sched, bool ALIGN_EPI = false, bool SP2 = false>
__device__ __forceinline__ void gemm_phase(PG8_LAS unsigned char* lds, const Gemm g, const Sched& S, const Epi& E) {
    const int tid = threadIdx.x, wid = __builtin_amdgcn_readfirstlane(tid >> 6), lane = tid & 63, wr = wid >> 2, wc = wid & 3, fr = lane & 15, fq = lane >> 4;
    const int K = g.K, nt = K / BK;
    unsigned voffA[2], voffB[2];
#pragma unroll
    for (int i = 0; i < 2; ++i) { int R, C; stage_rc(tid * 16 + i * 8192, R, C); const int Rb = Epi::PERM ? ((R & ~31) + perm32(R & 31)) : R;
        voffA[i] = (unsigned)(R * g.lda + C) * 2u; voffB[i] = (unsigned)(Rb * g.ldb + C) * 2u; }
    const size_t kstep = (size_t)(BK * 2);
    const size_t hstepA = (size_t)HALF * g.lda * 2, hstepB = (size_t)HALF * g.ldb * 2;
    const size_t tstepA = 2 * hstepA, tstepB = 2 * hstepB;
    const unsigned ldsw = (unsigned)wid * 1024u;
    const int aoff = lds_byte(wr * 64 + fr, fq * 8), boff = lds_byte(wc * 32 + fr, fq * 8);
#define PG8_SA(b, h) (((b) * 2 + (h)) * HTB)
#define PG8_SB(b, h) ((4 + (b) * 2 + (h)) * HTB)
#define PG8_STAGE(bufoff, gbase, voff) do { _Pragma("unroll") for (int _i = 0; _i < 2; ++_i) \
        __builtin_amdgcn_global_load_lds((const unsigned*)((const char*)(gbase) + (voff)[_i]), (PG8_LAS unsigned*)(lds + (bufoff) + ldsw + _i * 8192), 16, 0, 0); } while (0)
#define PG8_LDA(dst, b, h) do { _Pragma("unroll") for (int m = 0; m < 4; ++m) _Pragma("unroll") for (int k = 0; k < 2; ++k) dst[m][k] = *(const PG8_LAS bf16x8*)(lds + PG8_SA(b, h) + aoff + m * 2048 + k * 1024); } while (0)
#define PG8_LDB(dst, b, h) do { _Pragma("unroll") for (int n = 0; n < 2; ++n) _Pragma("unroll") for (int k = 0; k < 2; ++k) dst[n][k] = *(const PG8_LAS bf16x8*)(lds + PG8_SB(b, h) + boff + n * 2048 + k * 1024); } while (0)
#define PG8_MMA(ai, bj, At, Bt) do { __builtin_amdgcn_s_setprio(1); _Pragma("unroll") for (int m = 0; m < 4; ++m) _Pragma("unroll") for (int n = 0; n < 2; ++n) _Pragma("unroll") for (int k = 0; k < 2; ++k) \
        acc[ai][bj][m][n] = __builtin_amdgcn_mfma_f32_16x16x32_bf16(Bt[n][k], At[m][k], acc[ai][bj][m][n], 0, 0, 0); __builtin_amdgcn_s_setprio(0); } while (0)
#define PG8_WAIT_V(n) asm volatile("s_waitcnt vmcnt(" #n ")" ::: "memory")
#define PG8_WAIT_L(n) asm volatile("s_waitcnt lgkmcnt(" #n ")" ::: "memory")
#define PG8_BAR __builtin_amdgcn_s_barrier()
#define PG8_SCHED __builtin_amdgcn_sched_barrier(0)
    Unit cur, nxt; int ui = 0;
    if (!S.next(0, cur)) return;
    f32x4 acc[2][2][4][2];
#pragma unroll
    for (int a = 0; a < 2; ++a)
#pragma unroll
        for (int b = 0; b < 2; ++b)
#pragma unroll
            for (int m = 0; m < 4; ++m)
#pragma unroll
                for (int n = 0; n < 2; ++n) acc[a][b][m][n] = (f32x4){0.f, 0.f, 0.f, 0.f};
    bf16x8 At[4][2], B0[2][2], B1[2][2];
    const char* cA = (const char*)g.A + (size_t)cur.pm * tstepA; const char* cB = (const char*)g.Bt + (size_t)cur.pn * tstepB;
    S.a_ready(cur);
    if constexpr (SP2) {
        PG8_STAGE(PG8_SB(0, 0), cB, voffB); PG8_STAGE(PG8_SB(0, 1), cB + hstepB, voffB); PG8_STAGE(PG8_SA(0, 0), cA, voffA); PG8_STAGE(PG8_SA(0, 1), cA + hstepA, voffA);
        if (wr == 1) PG8_BAR;
        PG8_WAIT_V(2); PG8_BAR;
        PG8_STAGE(PG8_SB(1, 0), cB + kstep, voffB); PG8_STAGE(PG8_SA(1, 0), cA + kstep, voffA); PG8_STAGE(PG8_SB(1, 1), cB + hstepB + kstep, voffB);
        PG8_WAIT_V(6); PG8_BAR;
    } else {
        PG8_STAGE(PG8_SB(0, 0), cB, voffB); PG8_STAGE(PG8_SA(0, 0), cA, voffA); PG8_STAGE(PG8_SB(0, 1), cB + hstepB, voffB); PG8_STAGE(PG8_SA(0, 1), cA + hstepA, voffA);
        if (wr == 1) PG8_BAR;
        PG8_WAIT_V(4); PG8_BAR;
        PG8_STAGE(PG8_SB(1, 0), cB + kstep, voffB); PG8_STAGE(PG8_SA(1, 0), cA + kstep, voffA); PG8_STAGE(PG8_SB(1, 1), cB + hstepB + kstep, voffB);
        PG8_WAIT_V(6); PG8_BAR;
    }
    for (;;) {
        const bool has_next = S.next(ui + 1, nxt);
        const char* nA = has_next ? (const char*)g.A + (size_t)nxt.pm * tstepA : cA; const char* nB = has_next ? (const char*)g.Bt + (size_t)nxt.pn * tstepB : cB;
        for (int t = 0; t < nt; t += 2) {
            const bool last = (t == nt - 2);
            const char* a1 = cA + (size_t)(t + 1) * kstep;
            const char* a2 = last ? nA : cA + (size_t)(t + 2) * kstep; const char* b2 = last ? nB : cB + (size_t)(t + 2) * kstep;
            const char* a3 = a2 + kstep; const char* b3 = b2 + kstep;
            if (last && has_next) S.a_ready(nxt);
            if constexpr (Epi::HAS_MID) { if (t == (nt >> 1)) E.mid(acc, cur, wr, wc, fr, fq); }
            if constexpr (SP2) {
            PG8_LDB(B0, 0, 0); PG8_LDB(B1, 0, 1); PG8_SCHED; PG8_LDA(At, 0, 0); PG8_STAGE(PG8_SA(1, 1), a1 + hstepA, voffA);
            PG8_WAIT_V(8); PG8_WAIT_L(0); PG8_BAR; PG8_MMA(0, 0, At, B0); PG8_MMA(0, 1, At, B1); PG8_BAR; PG8_SCHED;
            PG8_LDA(At, 0, 1); PG8_STAGE(PG8_SB(0, 0), b2, voffB); PG8_STAGE(PG8_SB(0, 1), b2 + hstepB, voffB); PG8_STAGE(PG8_SA(0, 0), a2, voffA);
            PG8_WAIT_V(8); PG8_WAIT_L(0); PG8_BAR; PG8_MMA(1, 0, At, B0); PG8_MMA(1, 1, At, B1); PG8_BAR; PG8_SCHED;
            PG8_LDB(B0, 1, 0); PG8_LDB(B1, 1, 1); PG8_SCHED; PG8_LDA(At, 1, 0); PG8_STAGE(PG8_SA(0, 1), a2 + hstepA, voffA);
            PG8_WAIT_V(8); PG8_WAIT_L(0); PG8_BAR; PG8_MMA(0, 0, At, B0); PG8_MMA(0, 1, At, B1); PG8_BAR; PG8_SCHED;
            PG8_LDA(At, 1, 1); PG8_STAGE(PG8_SB(1, 0), b3, voffB); PG8_STAGE(PG8_SB(1, 1), b3 + hstepB, voffB); PG8_STAGE(PG8_SA(1, 0), a3, voffA);
            PG8_WAIT_V(8); PG8_WAIT_L(0); PG8_BAR; PG8_MMA(1, 0, At, B0); PG8_MMA(1, 1, At, B1); PG8_BAR; PG8_SCHED;
            } else {
            PG8_LDB(B0, 0, 0); PG8_SCHED; PG8_LDA(At, 0, 0); PG8_STAGE(PG8_SA(1, 1), a1 + hstepA, voffA);
            PG8_WAIT_L(8); PG8_BAR; PG8_WAIT_L(0); PG8_MMA(0, 0, At, B0); PG8_BAR; PG8_SCHED;
            PG8_LDB(B1, 0, 1); PG8_STAGE(PG8_SB(0, 0), b2, voffB);
            PG8_BAR; PG8_WAIT_L(0); PG8_MMA(0, 1, At, B1); PG8_BAR;
            PG8_LDA(At, 0, 1); PG8_STAGE(PG8_SA(0, 0), a2, voffA);
            PG8_BAR; PG8_WAIT_L(0); PG8_MMA(1, 0, At, B0); PG8_BAR; PG8_SCHED;
            PG8_STAGE(PG8_SB(0, 1), b2 + hstepB, voffB);
            PG8_WAIT_V(6); PG8_BAR; PG8_MMA(1, 1, At, B1); PG8_BAR;
            PG8_LDB(B0, 1, 0); PG8_SCHED; PG8_LDA(At, 1, 0); PG8_STAGE(PG8_SA(0, 1), a2 + hstepA, voffA);
            PG8_WAIT_L(8); PG8_BAR; PG8_WAIT_L(0); PG8_MMA(0, 0, At, B0); PG8_BAR; PG8_SCHED;
            PG8_LDB(B1, 1, 1); PG8_STAGE(PG8_SB(1, 0), b3, voffB);
            PG8_BAR; PG8_WAIT_L(0); PG8_MMA(0, 1, At, B1); PG8_BAR;
            PG8_LDA(At, 1, 1); PG8_STAGE(PG8_SA(1, 0), a3, voffA);
            PG8_BAR; PG8_WAIT_L(0); PG8_MMA(1, 0, At, B0); PG8_BAR; PG8_SCHED;
            PG8_STAGE(PG8_SB(1, 1), b3 + hstepB, voffB);
            PG8_WAIT_V(6); PG8_BAR; PG8_MMA(1, 1, At, B1); PG8_BAR;
            }
        }
        if constexpr (ALIGN_EPI) { if (wr == 0) PG8_BAR; }
        if constexpr (!Epi::AFTER_DRAIN) { E(acc, cur, wr, wc, fr, fq); S.done(cur); }
        if (!has_next) break;
#pragma unroll
        for (int a = 0; a < 2; ++a)
#pragma unroll
            for (int b = 0; b < 2; ++b)
#pragma unroll
                for (int m = 0; m < 4; ++m)
#pragma unroll
                    for (int n = 0; n < 2; ++n) acc[a][b][m][n] = (f32x4){0.f, 0.f, 0.f, 0.f};
        cur = nxt; cA = nA; cB = nB; ++ui;
        if constexpr (ALIGN_EPI) { if (wr == 1) PG8_BAR; }
    }
    PG8_WAIT_V(0);
    if constexpr (!ALIGN_EPI) { if (wr == 0) PG8_BAR; }
    PG8_BAR;
    if constexpr (Epi::AFTER_DRAIN) { E.fused(acc, cur, wr, wc, fr, fq, lds, wid, lane); S.done(cur); }
#undef PG8_SA
#undef PG8_SB
#undef PG8_STAGE
#undef PG8_LDA
#undef PG8_LDB
#undef PG8_MMA
#undef PG8_WAIT_V
#undef PG8_WAIT_L
#undef PG8_BAR
#undef PG8_SCHED
}
}
#ifndef PG8_SP2
#define PG8_SP2 true
#endif
#ifndef PG8_ALIGN
#define PG8_ALIGN true
#endif
#define GAS __attribute__((address_space(1)))
#define LAS __attribute__((address_space(3)))
typedef unsigned short bf16;
typedef unsigned v4u __attribute__((ext_vector_type(4)));
typedef float f32x4 __attribute__((ext_vector_type(4)));
typedef short bf16x8 __attribute__((ext_vector_type(8)));
typedef GAS unsigned gu32;
typedef GAS unsigned long long gu64;
#define RLX_AGENT __ATOMIC_RELAXED, __HIP_MEMORY_SCOPE_AGENT
#define LDS_WAIT() asm volatile("s_waitcnt lgkmcnt(0)" ::: "memory")
#define VM_WAIT() asm volatile("s_waitcnt vmcnt(0)" ::: "memory")
__device__ __forceinline__ unsigned long long rt() { return __builtin_amdgcn_s_memrealtime(); }
__device__ __forceinline__ unsigned f2bf(float f) { unsigned u = __builtin_bit_cast(unsigned, f); return (u + 0x7fffu + ((u >> 16) & 1u)) >> 16; }
__device__ __forceinline__ unsigned pk2(float lo, float hi) { return f2bf(lo) | (f2bf(hi) << 16); }
#define XB_TMO      128
#define XB_XCNT(j)  (256  + 64 * (j))
#define XB_XSUB(j)  (1280 + 64 * (j))
#define XB_XGEN(j)  (2304 + 64 * (j))
#define XB_TOP      3328
#define XB_TOPGEN   3392
#define XB_LSUB(j)  (3456 + 64 * (j))
#define XB_LGEN(j)  (4480 + 64 * (j))
#define XB_CLAIM(j) (5504 + 64 * (j))
#define XCD_BAR_WORDS 6656
#define XB_SPIN_CAP (1u << 18)

__device__ __forceinline__ unsigned xb_ld(unsigned* p)              { return __hip_atomic_load(p, __ATOMIC_RELAXED, __HIP_MEMORY_SCOPE_AGENT); }
__device__ __forceinline__ unsigned xb_add(unsigned* p, unsigned v) { return __hip_atomic_fetch_add(p, v, __ATOMIC_RELAXED, __HIP_MEMORY_SCOPE_AGENT); }
__device__ __forceinline__ unsigned xb_xcc_id() { return (unsigned)__builtin_amdgcn_s_getreg((3 << 11) | 20) & 0xFu; }
#define XB_SPIN(cond, bar) do { unsigned _sp = 0; while (cond) { __builtin_amdgcn_s_sleep(1); \
    if ((++_sp & 255u) == 0u) { if (xb_ld(&(bar)[XB_TMO])) break; if (_sp > XB_SPIN_CAP) { atomicAdd(&(bar)[XB_TMO], 1u); break; } } } } while (0)

struct XcdBarrier {
    unsigned* bar; unsigned x;
    volatile LAS unsigned* st;
};

__device__ __forceinline__ XcdBarrier xcd_barrier_post(unsigned* bar, volatile LAS unsigned* st) {
    XcdBarrier b; b.bar = bar; b.x = xb_xcc_id(); b.st = st;
    if (threadIdx.x == 0) (void)xb_add(&bar[XB_XCNT(b.x)], 1u);
    return b;
}
__device__ __forceinline__ void xcd_barrier_complete(unsigned* bar, unsigned x, unsigned& nloc, unsigned& nx, unsigned& uni) {
    const unsigned G = gridDim.x * gridDim.y * gridDim.z;
    unsigned sum, cnt, mine, even, sp = 0u;
    for (;;) {
        sum = 0u; cnt = 0u; mine = 0u; even = 1u;
#pragma unroll
        for (unsigned j = 0; j < 16; ++j) { const unsigned c = xb_ld(&bar[XB_XCNT(j)]); sum += c; cnt += (c > 0u) ? 1u : 0u; mine = (j == x) ? c : mine; even = (c != 0u && c * 8u != G) ? 0u : even; }
        if (sum == G) break;
        __builtin_amdgcn_s_sleep(1);
        if ((++sp & 255u) == 0u) { if (xb_ld(&bar[XB_TMO])) break; if (sp > XB_SPIN_CAP) { atomicAdd(&bar[XB_TMO], 1u); break; } }
    }
    nloc = mine > 0u ? mine : 1u; nx = cnt > 0u ? cnt : 1u;
    uni = (sum == G && cnt == 8u && even != 0u && (G & 7u) == 0u) ? 1u : 0u;
}

__device__ __forceinline__ void xcd_barrier(const XcdBarrier& b) {
    asm volatile("s_waitcnt vmcnt(0)" ::: "memory");
    __syncthreads();
    if (threadIdx.x == 0) {
        unsigned* bar = b.bar;
        __builtin_amdgcn_s_waitcnt(0);
        unsigned nloc = b.st[0], nx = b.st[1];
        if (nloc == 0u) { unsigned uni; xcd_barrier_complete(bar, b.x, nloc, nx, uni); b.st[0] = nloc; b.st[1] = nx; b.st[2] = uni; }
        const unsigned old = xb_add(&bar[XB_XSUB(b.x)], 1u);
        const unsigned gen = old / nloc;
        if (old + 1u == (gen + 1u) * nloc) {
            __builtin_amdgcn_fence(__ATOMIC_RELEASE, "agent");
            asm volatile("s_waitcnt vmcnt(0)" ::: "memory");
            const unsigned og = xb_add(&bar[XB_TOP], 1u);
            const unsigned tg = og / nx;
            if (og + 1u == (tg + 1u) * nx) xb_add(&bar[XB_TOPGEN], 1u);
            else XB_SPIN(xb_ld(&bar[XB_TOPGEN]) == tg, bar);
            __builtin_amdgcn_fence(__ATOMIC_ACQUIRE, "agent");
            xb_add(&bar[XB_XGEN(b.x)], 1u);
            asm volatile("s_waitcnt vmcnt(0)" ::: "memory");
        } else {
            XB_SPIN(xb_ld(&bar[XB_XGEN(b.x)]) == gen, bar);
            __builtin_amdgcn_fence(__ATOMIC_ACQUIRE, "agent");
            asm volatile("s_waitcnt vmcnt(0)" ::: "memory");
        }
    }
    __syncthreads();
}

__device__ __forceinline__ void xcd_barrier_local(const XcdBarrier& b) {
    asm volatile("s_waitcnt vmcnt(0)" ::: "memory");
    __syncthreads();
    if (threadIdx.x == 0) {
        unsigned* bar = b.bar;
        __builtin_amdgcn_s_waitcnt(0);
        const unsigned nloc = b.st[0];
        const unsigned old = xb_add(&bar[XB_LSUB(b.x)], 1u);
        const unsigned gen = old / nloc;
        if (old + 1u == (gen + 1u) * nloc) xb_add(&bar[XB_LGEN(b.x)], 1u);
        else XB_SPIN(xb_ld(&bar[XB_LGEN(b.x)]) == gen, bar);
        __builtin_amdgcn_fence(__ATOMIC_ACQUIRE, "agent");
        asm volatile("s_waitcnt vmcnt(0)" ::: "memory");
    }
    __syncthreads();
}


constexpr int NB = 16, SEQ = 4096, D = 1024, M = NB * SEQ;
constexpr int NIN = 7432, NPROJ = 7424, DFF = 2816, NFF2 = 5632;
constexpr float EPS = 1e-6f;
constexpr int NWAVES = 8;
constexpr size_t MiB = 1u << 20;
constexpr size_t WS_CTL = 0, CTL_ZERO_BYTES = 1 * MiB;
constexpr size_t WS_W1T = 2 * MiB, WS_WCAT = 17 * MiB  , WS_WOUT = 21 * MiB, WS_WFI = 23 * MiB, WS_WFO = 34 * MiB;
constexpr size_t WS_GATES = 40 * MiB;
constexpr size_t WS_ROPE = 42 * MiB;
constexpr size_t WS_SSQ2 = 43 * MiB;
constexpr size_t WS_MQK = 48 * MiB, WS_MVO = 304 * MiB, WS_AQ = 560 * MiB, WS_AKV = 688 * MiB, WS_GMA = 720 * MiB;
constexpr size_t WS_CAT = WS_MQK;
constexpr size_t WS_T = WS_MVO;
constexpr size_t WS_X1B = WS_MQK;
constexpr size_t WS_ACT = WS_AQ;
constexpr size_t WS_FREE = 976 * MiB;
constexpr size_t WS_END = 1024 * MiB;
static_assert(WS_W1T + (size_t)NPROJ * D * 2 <= WS_WCAT && WS_WFI + (size_t)NFF2 * D * 2 <= WS_WFO && WS_WFO + (size_t)D * DFF * 2 <= WS_GATES, "weights map");
static_assert(WS_ACT + (size_t)M * DFF * 2 <= WS_FREE && WS_GMA + (size_t)M * 2048 * 2 <= WS_FREE, "ws map");
constexpr int CW_BAR = 4096;
constexpr int RING_OFF = 0, RING_BYTES = 131072, LDSCTL_OFF = RING_BYTES, MISC_OFF = LDSCTL_OFF + 320, LDSCTL_BYTES = 1024, XTRA_OFF = LDSCTL_OFF + LDSCTL_BYTES, LDS_BYTES = 163840;

typedef GAS float gf32;

__device__ __forceinline__ float wave_sum(float v) {
#pragma unroll
    for (int o = 1; o < 64; o <<= 1) v += __shfl_xor(v, o);
    return v;
}
__device__ __forceinline__ float bf2f(bf16 b) { return __uint_as_float(((unsigned)b) << 16); }

struct Frame {
    LAS unsigned char* lds;
    volatile LAS unsigned* MISC;
    gu32* ctl;
    int tid, lane, wave, vcu, G;
};

__device__ __forceinline__ void p0_transpose_item(const float* W, int ldw, int csrc, int K, bf16* WT, int ndst, int k0, const float* rowscale, LAS float* scr, int lane) {
#pragma unroll
    for (int i = 0; i < 32; ++i) { const int kk = 2 * i + (lane >> 5); float v = W[(size_t)(k0 + kk) * ldw + csrc + (lane & 31)]; if (rowscale) v *= rowscale[k0 + kk]; scr[kk * 33 + (lane & 31)] = v; }
    LDS_WAIT(); asm volatile("" ::: "memory");
    const int c = lane & 7;
#pragma unroll
    for (int j = 0; j < 4; ++j) { const int n = (lane >> 3) + 8 * j; const LAS float* s = scr + (8 * c) * 33 + n;
        v4u o; o.x = pk2(s[0 * 33], s[1 * 33]); o.y = pk2(s[2 * 33], s[3 * 33]); o.z = pk2(s[4 * 33], s[5 * 33]); o.w = pk2(s[6 * 33], s[7 * 33]);
        *(GAS v4u*)(WT + (size_t)(ndst + n) * K + k0 + 8 * c) = o; }
    LDS_WAIT(); asm volatile("" ::: "memory");
}

struct Args { const float* in[17]; float* out; unsigned char* ws; int ph_lo, ph_hi, li, pad; };

__device__ __forceinline__ void p0_prologue(Frame& F, const Args& A) {
    unsigned char* ws = A.ws;
    LAS float* scr = (LAS float*)(F.lds + RING_OFF + F.wave * 16384);
    const int gw = F.vcu * NWAVES + F.wave, NGW = F.G * NWAVES;
    constexpr int I_IN = 16 * (NPROJ / 32), I_SQ = 16 * 32, I_FI = 16 * (NFF2 / 32), I_FO = (DFF / 64) * 32;
    constexpr int NITEMS = I_IN + 3 * I_SQ + I_FI + I_FO;
    for (int it = gw; it < NITEMS; it += NGW) {
        int r = it;
        if (r < I_IN) { const int nb = r % (NPROJ / 32), kb = r / (NPROJ / 32), n0 = 32 * nb; int csrc = n0 + (n0 >= 4096 ? 8 : 0);
            if (n0 >= 5376) { const int q = (n0 - 5376) >> 8, c = (n0 - 5376) & 255; csrc = (c < 128) ? 5384 + 128 * q + c : 6408 + 128 * q + (c - 128); }
            p0_transpose_item(A.in[2], NIN, csrc, D, (bf16*)(ws + WS_W1T), n0, 64 * kb, nullptr, scr, F.lane); continue; } r -= I_IN;
        if (r < I_SQ) { p0_transpose_item(A.in[11], D, 32 * (r % 32), 2048, (bf16*)(ws + WS_WCAT) + 1024, 32 * (r % 32), 64 * (r / 32), A.in[6], scr, F.lane); continue; } r -= I_SQ;
        if (r < I_SQ) { p0_transpose_item(A.in[12], D, 32 * (r % 32), 2048, (bf16*)(ws + WS_WCAT), 32 * (r % 32), 64 * (r / 32), nullptr, scr, F.lane); continue; } r -= I_SQ;
        if (r < I_SQ) { p0_transpose_item(A.in[13], D, 32 * (r % 32), D, (bf16*)(ws + WS_WOUT), 32 * (r % 32), 64 * (r / 32), nullptr, scr, F.lane); continue; } r -= I_SQ;
        if (r < I_FI) { const int nb = r % (NFF2 / 32), kb = r / (NFF2 / 32), n0 = 32 * nb, tile = n0 >> 8, c = n0 & 255;
            const int csrc = (c < 128) ? 128 * tile + c : DFF + 128 * tile + (c - 128);
            p0_transpose_item(A.in[15], NFF2, csrc, D, (bf16*)(ws + WS_WFI), n0, 64 * kb, A.in[14], scr, F.lane); continue; } r -= I_FI;
        p0_transpose_item(A.in[16], D, 32 * (r % 32), DFF, (bf16*)(ws + WS_WFO), 32 * (r % 32), 64 * (r / 32), nullptr, scr, F.lane);
    }
    { const int idx = blockIdx.x * (NWAVES * 64) + F.tid;
      if (idx < SEQ * 8) { const int pos = idx >> 3, i = idx & 7;
        const double invf[8] = {1.0, 0.19392274474868576, 0.03760603093086393, 0.007292664737217109, 0.001414213562373095, 0.0002742481756762073, 5.318295896944988e-05, 1.031338537721246e-05};
        double f = invf[0];
#pragma unroll
        for (int q = 1; q < 8; ++q) f = (i == q) ? invf[q] : f;
        double t = (double)pos * f * 0.15915494309189535; t -= __builtin_rint(t);
        float2 cs; cs.x = __builtin_amdgcn_cosf((float)t); cs.y = __builtin_amdgcn_sinf((float)t);
        ((float2*)(ws + WS_ROPE))[idx] = cs; } }
    __syncthreads();
    LAS float* gwa = (LAS float*)(F.lds + RING_OFF); LAS float* gwb = gwa + 4096;
    for (int idx = F.tid; idx < 1024 * 8; idx += NWAVES * 64) { const int k = idx >> 3, c = idx & 7; const float v = A.in[2][(size_t)k * NIN + 4096 + c];
        const int j = k >> 8, ln = (k >> 2) & 63, i = k & 3; LAS float* dst = (c < 4) ? gwa : gwb; dst[((j * 4 + i) * 64 + ln) * 4 + (c & 3)] = v; }
    __syncthreads();
    const float* x = A.in[0]; const float* g1 = A.in[1]; const float* bg = A.in[5];
    bf16* H1 = (bf16*)A.out; float* gates = (float*)(ws + WS_GATES);
    f32x4 gv[4];
#pragma unroll
    for (int j = 0; j < 4; ++j) gv[j] = ((const GAS f32x4*)g1)[F.lane + 64 * j];
    constexpr int RB = 4;
    for (int m0 = gw * RB; m0 < M; m0 += NGW * RB) {
        f32x4 v[RB][4];
#pragma unroll
        for (int rr = 0; rr < RB; ++rr) { const GAS f32x4* xr = (const GAS f32x4*)(x + (size_t)(m0 + rr) * D) + F.lane;
#pragma unroll
            for (int j = 0; j < 4; ++j) v[rr][j] = xr[64 * j]; }
#pragma unroll
        for (int rr = 0; rr < RB; ++rr) { const int m = m0 + rr; float s = 0.f;
#pragma unroll
            for (int j = 0; j < 4; ++j) s += (v[rr][j].x * v[rr][j].x + v[rr][j].y * v[rr][j].y) + (v[rr][j].z * v[rr][j].z + v[rr][j].w * v[rr][j].w);
            const float rstd = 1.0f / sqrtf(wave_sum(s) * (1.0f / D) + EPS);
            GAS unsigned long long* o8 = (GAS unsigned long long*)(H1 + (size_t)m * D) + F.lane;
            float ga[8];
#pragma unroll
            for (int c = 0; c < 8; ++c) ga[c] = 0.f;
#pragma unroll
            for (int j = 0; j < 4; ++j) { const f32x4 hv4 = v[rr][j] * rstd * gv[j];
                o8[64 * j] = (unsigned long long)pk2(hv4.x, hv4.y) | ((unsigned long long)pk2(hv4.z, hv4.w) << 32);
#pragma unroll
                for (int i = 0; i < 4; ++i) { const f32x4 wa = *(const LAS f32x4*)(gwa + ((j * 4 + i) * 64 + F.lane) * 4), wb = *(const LAS f32x4*)(gwb + ((j * 4 + i) * 64 + F.lane) * 4);
                    const float hv = hv4[i];
                    ga[0] += hv * wa[0]; ga[1] += hv * wa[1]; ga[2] += hv * wa[2]; ga[3] += hv * wa[3];
                    ga[4] += hv * wb[0]; ga[5] += hv * wb[1]; ga[6] += hv * wb[2]; ga[7] += hv * wb[3]; } }
            float gh[4];
#pragma unroll
            for (int c = 0; c < 4; ++c) { const float mine = (F.lane < 32) ? ga[c] : ga[4 + c], send = (F.lane < 32) ? ga[4 + c] : ga[c]; gh[c] = mine + __shfl_xor(send, 32); }
#pragma unroll
            for (int c = 0; c < 4; ++c) {
#pragma unroll
                for (int o = 1; o < 32; o <<= 1) gh[c] += __shfl_xor(gh[c], o); }
            if ((F.lane & 31) < 4) { const int c = F.lane & 3; float val = gh[0];
                val = (c == 1) ? gh[1] : val; val = (c == 2) ? gh[2] : val; val = (c == 3) ? gh[3] : val;
                const int gi = (F.lane >> 5) * 4 + c;
                val += bg[gi];
                if (gi >= 4) val = fminf(val, 0.f) - log1pf(__expf(-fabsf(val)));
                gates[(size_t)m * 8 + gi] = val; }
        }
    }
}

__device__ __forceinline__ void unpack8(const v4u w, float* f) {
    f[0] = __uint_as_float(w.x << 16); f[1] = __uint_as_float(w.x & 0xffff0000u); f[2] = __uint_as_float(w.y << 16); f[3] = __uint_as_float(w.y & 0xffff0000u);
    f[4] = __uint_as_float(w.z << 16); f[5] = __uint_as_float(w.z & 0xffff0000u); f[6] = __uint_as_float(w.w << 16); f[7] = __uint_as_float(w.w & 0xffff0000u); }
typedef float f32x16 __attribute__((ext_vector_type(16)));
typedef short s16x4 __attribute__((ext_vector_type(4)));
__device__ __forceinline__ unsigned cvtpk(float lo, float hi) { typedef float f2_t __attribute__((ext_vector_type(2))); typedef __bf16 b2_t __attribute__((ext_vector_type(2)));
    f2_t v = {lo, hi}; b2_t b = __builtin_convertvector(v, b2_t); return __builtin_bit_cast(unsigned, b); }
__device__ __forceinline__ int crow(int r, int hi) { return (r & 3) + 8 * (r >> 2) + 4 * hi; }
__device__ __forceinline__ bf16x8 tr_pair(const LAS unsigned char* p, int hi_off) {
    const s16x4 lo = __builtin_bit_cast(s16x4, __builtin_amdgcn_ds_read_tr16_b64_v4i16((LAS s16x4*)(p)));
    const s16x4 hi = __builtin_bit_cast(s16x4, __builtin_amdgcn_ds_read_tr16_b64_v4i16((LAS s16x4*)(p + hi_off)));
    return (bf16x8){lo[0], lo[1], lo[2], lo[3], hi[0], hi[1], hi[2], hi[3]}; }
constexpr int AT_KPITCH = 144, AT_K_OFF = 0, AT_V_OFF = 256 * AT_KPITCH, AT_VBLK = 256 * 64, AT_OST_OFF = AT_V_OFF + 2 * AT_VBLK, AT_UNITS = NB * 2 * (SEQ / 128);
static_assert(AT_OST_OFF + 8 * 4096 <= RING_BYTES, "attention LDS");

__device__ __forceinline__ void attn_phase(Frame& F, const bf16* AQ, const bf16* AKV, const float* qg, const float* kg, const float* sinks, const float2* rope, bf16* YA, bf16* YMN) {
    LAS unsigned char* L = F.lds + RING_OFF;
    const int lane = F.lane, r = lane & 31, h = lane >> 5, w = F.wave;
    const int lrow = F.tid >> 1, lhalf = F.tid & 1;
    const int per = (AT_UNITS + F.G - 1) / F.G;
    for (int it = 0; it < per; ++it) {
        const int unit = F.vcu * per + it; if (unit >= AT_UNITS) break;
        const int b = unit >> 6, kvh = (unit >> 5) & 1, qblk = unit & 31, q0 = qblk * 128;
        {
            const int kpos = q0 - 128 + lrow; const bool valid = kpos >= 0; const int kpc = valid ? kpos : 0;
            const size_t rowg = (size_t)b * SEQ + kpc;
            const GAS v4u* ks = (const GAS v4u*)(AKV + rowg * 256 + kvh * 64 + lhalf * 32);
            const GAS v4u* vs = (const GAS v4u*)(AKV + rowg * 256 + 128 + kvh * 64 + lhalf * 32);
            v4u kw[4], vw[4];
#pragma unroll
            for (int q = 0; q < 4; ++q) { kw[q] = ks[q]; vw[q] = vs[q]; }
            float y[32]; float ss = 0.f;
#pragma unroll
            for (int q = 0; q < 4; ++q) {
                y[8 * q + 0] = __uint_as_float(kw[q].x << 16); y[8 * q + 1] = __uint_as_float(kw[q].x & 0xffff0000u); y[8 * q + 2] = __uint_as_float(kw[q].y << 16); y[8 * q + 3] = __uint_as_float(kw[q].y & 0xffff0000u);
                y[8 * q + 4] = __uint_as_float(kw[q].z << 16); y[8 * q + 5] = __uint_as_float(kw[q].z & 0xffff0000u); y[8 * q + 6] = __uint_as_float(kw[q].w << 16); y[8 * q + 7] = __uint_as_float(kw[q].w & 0xffff0000u); }
#pragma unroll
            for (int i = 0; i < 32; ++i) ss += y[i] * y[i];
            ss += __shfl_xor(ss, 1);
            const float rstd = 1.0f / sqrtf(ss * (1.0f / 64.0f) + EPS);
#pragma unroll
            for (int q = 0; q < 8; ++q) { const f32x4 g = *(const GAS f32x4*)(kg + lhalf * 32 + 4 * q);
                y[4 * q] *= rstd * g[0]; y[4 * q + 1] *= rstd * g[1]; y[4 * q + 2] *= rstd * g[2]; y[4 * q + 3] *= rstd * g[3]; }
            if (lhalf == 0) {
#pragma unroll
                for (int i = 0; i < 8; ++i) { const float2 cs = rope[kpc * 8 + i]; const float x1 = y[i], x2 = y[8 + i]; y[i] = x1 * cs.x - x2 * cs.y; y[8 + i] = x2 * cs.x + x1 * cs.y; } }
            LAS v4u* kd = (LAS v4u*)(L + AT_K_OFF + lrow * AT_KPITCH + lhalf * 64);
            LAS v4u* vd = (LAS v4u*)(L + AT_V_OFF + lhalf * AT_VBLK + lrow * 64);
#pragma unroll
            for (int q = 0; q < 4; ++q) { v4u o; o.x = cvtpk(y[8 * q], y[8 * q + 1]); o.y = cvtpk(y[8 * q + 2], y[8 * q + 3]); o.z = cvtpk(y[8 * q + 4], y[8 * q + 5]); o.w = cvtpk(y[8 * q + 6], y[8 * q + 7]);
                if (!valid) { o = (v4u){0u, 0u, 0u, 0u}; vw[q] = (v4u){0u, 0u, 0u, 0u}; }
                kd[q] = o; vd[q] = vw[q]; }
        }
        GAS v4u* ymp = (GAS v4u*)(YMN + (size_t)((unit * 8 + w) * 8) * 2048) + lane;
        __syncthreads();
        const int hq = kvh * 8 + w; const float sink = sinks[hq];
        const GAS v4u* qs0 = (const GAS v4u*)(AQ + ((size_t)b * SEQ + q0 + r) * 1024 + hq * 64 + 8 * h);
        v4u qnx[4];
#pragma unroll
        for (int s = 0; s < 4; ++s) qnx[s] = qs0[2 * s];
#pragma unroll 1
        for (int j = 0; j < 4; ++j) {
            const int pos = q0 + 32 * j + r;
            v4u ymw[2][2];
#pragma unroll
            for (int rr = 0; rr < 2; ++rr) { ymw[rr][0] = ymp[(size_t)(2 * j + rr) * 256]; ymw[rr][1] = ymp[(size_t)(2 * j + rr) * 256 + 64]; }
            bf16x8 qf[4];
            {
                v4u qw[4];
#pragma unroll
                for (int s = 0; s < 4; ++s) qw[s] = qnx[s];
                if (j < 3) {
#pragma unroll
                    for (int s = 0; s < 4; ++s) qnx[s] = qs0[(size_t)(j + 1) * 4096 + 2 * s]; }
                float x[32]; float ss = 0.f;
#pragma unroll
                for (int s = 0; s < 4; ++s) {
                    x[8 * s + 0] = __uint_as_float(qw[s].x << 16); x[8 * s + 1] = __uint_as_float(qw[s].x & 0xffff0000u); x[8 * s + 2] = __uint_as_float(qw[s].y << 16); x[8 * s + 3] = __uint_as_float(qw[s].y & 0xffff0000u);
                    x[8 * s + 4] = __uint_as_float(qw[s].z << 16); x[8 * s + 5] = __uint_as_float(qw[s].z & 0xffff0000u); x[8 * s + 6] = __uint_as_float(qw[s].w << 16); x[8 * s + 7] = __uint_as_float(qw[s].w & 0xffff0000u); }
#pragma unroll
                for (int i = 0; i < 32; ++i) ss += x[i] * x[i];
                ss += __shfl_xor(ss, 32);
                const float rstd = 0.125f / sqrtf(ss * (1.0f / 64.0f) + EPS);
#pragma unroll
                for (int s = 0; s < 4; ++s) { const f32x4 g0 = *(const GAS f32x4*)(qg + 16 * s + 8 * h), g1 = *(const GAS f32x4*)(qg + 16 * s + 8 * h + 4);
                    x[8 * s + 0] *= rstd * g0[0]; x[8 * s + 1] *= rstd * g0[1]; x[8 * s + 2] *= rstd * g0[2]; x[8 * s + 3] *= rstd * g0[3];
                    x[8 * s + 4] *= rstd * g1[0]; x[8 * s + 5] *= rstd * g1[1]; x[8 * s + 6] *= rstd * g1[2]; x[8 * s + 7] *= rstd * g1[3]; }
#pragma unroll
                for (int i = 0; i < 8; ++i) { const float2 cs = rope[pos * 8 + i]; const float mine = x[i], other = __shfl_xor(mine, 32);
                    x[i] = (h == 0) ? (mine * cs.x - other * cs.y) : (mine * cs.x + other * cs.y); }
#pragma unroll
                for (int s = 0; s < 4; ++s) { v4u o; o.x = cvtpk(x[8 * s], x[8 * s + 1]); o.y = cvtpk(x[8 * s + 2], x[8 * s + 3]); o.z = cvtpk(x[8 * s + 4], x[8 * s + 5]); o.w = cvtpk(x[8 * s + 6], x[8 * s + 7]);
                    qf[s] = __builtin_bit_cast(bf16x8, o); }
            }
            f32x16 sc[5];
#pragma unroll
            for (int c = 0; c < 5; ++c) {
                f32x16 a = {0.f, 0.f, 0.f, 0.f, 0.f, 0.f, 0.f, 0.f, 0.f, 0.f, 0.f, 0.f, 0.f, 0.f, 0.f, 0.f};
                const LAS unsigned char* kp = L + AT_K_OFF + (32 * (j + c) + r) * AT_KPITCH + 16 * h;
                bf16x8 kf[4];
#pragma unroll
                for (int s = 0; s < 4; ++s) kf[s] = *(const LAS bf16x8*)(kp + 32 * s);
                __builtin_amdgcn_sched_barrier(0);
#pragma unroll
                for (int s = 0; s < 4; ++s) a = __builtin_amdgcn_mfma_f32_32x32x16_bf16(kf[s], qf[s], a, 0, 0, 0);
                sc[c] = a;
            }
            const float NEG = -INFINITY;
#pragma unroll
            for (int i = 0; i < 16; ++i) { const int kk = crow(i, h); if (!(kk > r)) sc[0][i] = NEG; if (!(kk <= r)) sc[4][i] = NEG; }
            if (qblk == 0) {
#pragma unroll
                for (int c = 0; c < 4; ++c) { if (32 * (j + c) < 128) {
#pragma unroll
                    for (int i = 0; i < 16; ++i) sc[c][i] = NEG; } } }
            float mx = sink;
#pragma unroll
            for (int c = 0; c < 5; ++c)
#pragma unroll
                for (int i = 0; i < 16; ++i) mx = fmaxf(mx, sc[c][i]);
            mx = fmaxf(mx, __shfl_xor(mx, 32));
            float l = 0.f;
#pragma unroll
            for (int c = 0; c < 5; ++c)
#pragma unroll
                for (int i = 0; i < 16; ++i) { const float p = __expf(sc[c][i] - mx); sc[c][i] = p; l += p; }
            l += __shfl_xor(l, 32);
            l += __expf(sink - mx);
            const float linv = 1.0f / l;
            f32x16 o0 = {0.f, 0.f, 0.f, 0.f, 0.f, 0.f, 0.f, 0.f, 0.f, 0.f, 0.f, 0.f, 0.f, 0.f, 0.f, 0.f}, o1 = o0;
            const int vlane = (4 * h + ((lane & 15) >> 2)) * 64 + (((lane >> 4) & 1) * 16 + 4 * (lane & 3)) * 2;
#pragma unroll
            for (int c = 0; c < 5; ++c) {
                bf16x8 v0[2], v1[2];
#pragma unroll
                for (int s = 0; s < 2; ++s) { const LAS unsigned char* vp = L + AT_V_OFF + (32 * (j + c) + 16 * s) * 64 + vlane;
                    v0[s] = tr_pair(vp, 512); v1[s] = tr_pair(vp + AT_VBLK, 512); }
                __builtin_amdgcn_sched_barrier(0);
#pragma unroll
                for (int s = 0; s < 2; ++s) {
                    v4u pw; pw.x = cvtpk(sc[c][8 * s] * linv, sc[c][8 * s + 1] * linv); pw.y = cvtpk(sc[c][8 * s + 2] * linv, sc[c][8 * s + 3] * linv);
                    pw.z = cvtpk(sc[c][8 * s + 4] * linv, sc[c][8 * s + 5] * linv); pw.w = cvtpk(sc[c][8 * s + 6] * linv, sc[c][8 * s + 7] * linv);
                    const bf16x8 pa = __builtin_bit_cast(bf16x8, pw);
                    o0 = __builtin_amdgcn_mfma_f32_32x32x16_bf16(pa, v0[s], o0, 0, 0, 0);
                    o1 = __builtin_amdgcn_mfma_f32_32x32x16_bf16(pa, v1[s], o1, 0, 0, 0);
                }
            }
            {
                LAS unsigned char* ost = L + AT_OST_OFF + w * 4096;
#pragma unroll
                for (int i = 0; i < 16; ++i) { const int qq = crow(i, h);
                    *(LAS unsigned short*)(ost + qq * 128 + 2 * r) = (unsigned short)f2bf(o0[i]); *(LAS unsigned short*)(ost + qq * 128 + 64 + 2 * r) = (unsigned short)f2bf(o1[i]); }
                bf16* yo = YA + ((size_t)b * SEQ + q0 + 32 * j) * 2048 + hq * 64;
#pragma unroll
                for (int q4 = 0; q4 < 4; ++q4) { const int row = 8 * q4 + (lane >> 3), ch = lane & 7;
                    *(GAS v4u*)(yo + (size_t)row * 2048 + 8 * ch) = *(const LAS v4u*)(ost + row * 128 + 16 * ch); }
            }
#pragma unroll
            for (int rr = 0; rr < 2; ++rr) {
#pragma unroll
                for (int j2 = 0; j2 < 2; ++j2) { float f[8]; unpack8(ymw[rr][j2], f); float ss = 0.f;
#pragma unroll
                    for (int i = 0; i < 8; ++i) ss += f[i] * f[i];
#pragma unroll
                    for (int o = 1; o < 32; o <<= 1) ss += __shfl_xor(ss, o);
                    const float rstd = 1.0f / sqrtf(ss * (1.0f / 256.0f) + EPS);
                    v4u o4; o4.x = cvtpk(f[0] * rstd, f[1] * rstd); o4.y = cvtpk(f[2] * rstd, f[3] * rstd); o4.z = cvtpk(f[4] * rstd, f[5] * rstd); o4.w = cvtpk(f[6] * rstd, f[7] * rstd);
                    ymp[(size_t)(2 * j + rr) * 256 + 64 * j2] = o4; } }
        }
        __syncthreads();
    }
}


__device__ __forceinline__ void conv_phase(Frame& F, const bf16* MQK, const float* cw, const float* cb, bf16* QKC) {
    constexpr int NITEM = NB * (SEQ / 32) * 4;
    const int ngrp = (F.G % 8 == 0) ? 8 : 1, gsz = F.G / ngrp, xg = F.vcu / gsz, lw = (F.vcu % gsz) * NWAVES + F.wave, lnw = gsz * NWAVES;
    for (int il = lw; il < NITEM / ngrp; il += lnw) { const int it = xg * (NITEM / ngrp) + il;
        const int cblk = it & 3, tb = (it >> 2) & (SEQ / 32 - 1), b = it >> 9;
        const int c0 = cblk * 512 + F.lane * 8;
        float w0[8], w1[8], w2[8], w3[8], bb[8];
#pragma unroll
        for (int q = 0; q < 2; ++q) { const f32x4 a0 = *(const GAS f32x4*)(cw + c0 + 4 * q), a1 = *(const GAS f32x4*)(cw + 2048 + c0 + 4 * q), a2 = *(const GAS f32x4*)(cw + 4096 + c0 + 4 * q), a3 = *(const GAS f32x4*)(cw + 6144 + c0 + 4 * q), a4 = *(const GAS f32x4*)(cb + c0 + 4 * q);
#pragma unroll
            for (int i = 0; i < 4; ++i) { w0[4 * q + i] = a0[i]; w1[4 * q + i] = a1[i]; w2[4 * q + i] = a2[i]; w3[4 * q + i] = a3[i]; bb[4 * q + i] = a4[i]; } }
        const float osc = (c0 >= 1024) ? 0.0625f : 1.0f;
        const size_t row0 = (size_t)b * SEQ + tb * 32;
        const GAS v4u* src = (const GAS v4u*)(MQK + row0 * 2048 + c0);
        GAS v4u* dst = (GAS v4u*)(QKC + row0 * 2048 + c0);
        float x0[8], x1[8], x2[8];
        if (tb == 0) {
#pragma unroll
            for (int i = 0; i < 8; ++i) { x0[i] = 0.f; x1[i] = 0.f; x2[i] = 0.f; }
        } else { unpack8(*(src - 3 * 256), x0); unpack8(*(src - 2 * 256), x1); unpack8(*(src - 1 * 256), x2); }
        v4u raw[8], nxt[8];
#pragma unroll
        for (int rr = 0; rr < 8; ++rr) raw[rr] = src[(size_t)rr * 256];
#pragma unroll
        for (int g8 = 0; g8 < 4; ++g8) {
            if (g8 < 3) {
#pragma unroll
                for (int rr = 0; rr < 8; ++rr) nxt[rr] = src[(size_t)(g8 * 8 + 8 + rr) * 256]; }
#pragma unroll
            for (int rr = 0; rr < 8; ++rr) { float x3[8], y[8]; unpack8(raw[rr], x3);
#pragma unroll
                for (int i = 0; i < 8; ++i) { const float v = bb[i] + w0[i] * x0[i] + w1[i] * x1[i] + w2[i] * x2[i] + w3[i] * x3[i];
                    y[i] = osc * v * __builtin_amdgcn_rcpf(1.0f + __expf(-v)); x0[i] = x1[i]; x1[i] = x2[i]; x2[i] = x3[i]; }
                v4u o; o.x = cvtpk(y[0], y[1]); o.y = cvtpk(y[2], y[3]); o.z = cvtpk(y[4], y[5]); o.w = cvtpk(y[6], y[7]);
                dst[(size_t)(g8 * 8 + rr) * 256] = o; }
            if (g8 < 3) {
#pragma unroll
                for (int rr = 0; rr < 8; ++rr) raw[rr] = nxt[rr]; }
        }
    }
}

constexpr int ML_QP = 528, ML_VP = 144;
constexpr int ML_QS = 0, ML_KS = 64 * ML_QP, ML_VT = ML_KS + 80 * ML_QP, ML_VWT = ML_VT + 80 * ML_VP, ML_SS = ML_VWT + 80 * ML_VP, ML_RED = ML_SS + 64 * ML_VP, ML_TAB = ML_RED + 16384, ML_END = ML_TAB + 2 * 2048;
static_assert(ML_END <= RING_BYTES, "mLSTM LDS");
constexpr int ML_OG = XTRA_OFF, ML_OT = XTRA_OFF + 2 * 64 * ML_VP;
static_assert(ML_OT + 64 * ML_VP <= LDS_BYTES, "mLSTM extra LDS");
constexpr int T_G = 0, T_MU = 256, T_ISC = 512, T_FLO = 768, T_QN = 1024, T_DP = 1280;
typedef float f32x4v __attribute__((ext_vector_type(4)));
typedef unsigned u32x2v __attribute__((ext_vector_type(2)));
#define MFMA16(a, b, c) __builtin_amdgcn_mfma_f32_16x16x32_bf16((a), (b), (c), 0, 0, 0)

template <int CTRL> __device__ __forceinline__ float dpp_shr(float src, float ident) {
    return __int_as_float(__builtin_amdgcn_update_dpp(__float_as_int(ident), __float_as_int(src), CTRL, 0xf, 0xf, false)); }
__device__ __forceinline__ float wave_scan_sum(float x, int lane) {
    x += dpp_shr<0x111>(x, 0.f); x += dpp_shr<0x112>(x, 0.f); x += dpp_shr<0x114>(x, 0.f); x += dpp_shr<0x118>(x, 0.f);
    const float t15 = __int_as_float(__builtin_amdgcn_readlane(__float_as_int(x), 15)), t47 = __int_as_float(__builtin_amdgcn_readlane(__float_as_int(x), 47));
    const int row = lane >> 4; x += (row == 1) ? t15 : ((row == 3) ? t47 : 0.f);
    const float t31 = __int_as_float(__builtin_amdgcn_readlane(__float_as_int(x), 31)); x += (row >= 2) ? t31 : 0.f;
    return x; }
__device__ __forceinline__ float wave_scan_max(float x, int lane) {
    const float NI = -INFINITY;
    x = fmaxf(x, dpp_shr<0x111>(x, NI)); x = fmaxf(x, dpp_shr<0x112>(x, NI)); x = fmaxf(x, dpp_shr<0x114>(x, NI)); x = fmaxf(x, dpp_shr<0x118>(x, NI));
    const float t15 = __int_as_float(__builtin_amdgcn_readlane(__float_as_int(x), 15)), t47 = __int_as_float(__builtin_amdgcn_readlane(__float_as_int(x), 47));
    const int row = lane >> 4; x = fmaxf(x, (row == 1) ? t15 : ((row == 3) ? t47 : NI));
    const float t31 = __int_as_float(__builtin_amdgcn_readlane(__float_as_int(x), 31)); x = fmaxf(x, (row >= 2) ? t31 : NI);
    return x; }

__device__ __forceinline__ void mlstm_phase(Frame& F, const bf16* QKC, const bf16* MVO, const float* gates, bf16* HM) {
    LAS unsigned char* L = F.lds + RING_OFF;
    const int tid = F.tid, lane = F.lane, w = F.wave, l15 = lane & 15, kg = lane >> 4, e16 = w & 3, hf = w >> 2;
    const f32x4v Z4 = {0.f, 0.f, 0.f, 0.f};
    const int bt = w & 3;
    const int qtt = (hf == 1 && bt == 0) ? 3 : bt;
    const int tA = (hf == 0) ? 0 : ((bt < 2) ? 4 : 2);
    const int tB = (hf == 0) ? ((bt == 0) ? 4 : 1) : ((bt < 2) ? -1 : ((bt == 2) ? 4 : 3));
    for (int unit = F.vcu; unit < NB * 4 * 4; unit += F.G) {
        const int es = unit & 3, h = (unit >> 2) & 3, b = unit >> 4;
        for (int i = tid; i < 16 * ML_QP / 4; i += NWAVES * 64) ((LAS unsigned*)(L + ML_KS + 64 * ML_QP))[i] = 0u;
        for (int i = tid; i < 16 * ML_VP / 4; i += NWAVES * 64) { ((LAS unsigned*)(L + ML_VT + 64 * ML_VP))[i] = (i < ML_VP / 4) ? 0x3f803f80u : 0u; ((LAS unsigned*)(L + ML_VWT + 64 * ML_VP))[i] = 0u; }
        for (int i = tid; i < 64 * ML_VP / 4; i += NWAVES * 64) ((LAS unsigned*)(L + ML_SS))[i] = 0u;
        f32x4v Cacc[8], nacc[2];
#pragma unroll
        for (int i = 0; i < 8; ++i) Cacc[i] = Z4;
        nacc[0] = Z4; nacc[1] = Z4;
        float m_run = 0.f;
        const int prow = tid >> 3, pseg = tid & 7, vs_ = tid & 63, veg = tid >> 6;
        const size_t seq0 = (size_t)b * SEQ;
        const bf16* qsrc = QKC + (seq0 + prow) * 2048 + h * 256 + pseg * 8;
        const bf16* vsrc = MVO + (seq0 + vs_) * 2048 + h * 256 + es * 64 + veg * 8;
        const bf16* osrc = MVO + (seq0 + prow) * 2048 + 1024 + h * 256 + es * 64 + pseg * 8;
        bf16* odst = HM + (seq0 + prow) * 2048 + h * 256 + es * 64 + pseg * 8;
        const float* gsrc = gates + (seq0 + lane) * 8 + h;
        v4u pq[4], pk[4], pv, po; float pgi, pgf;
#define ML_PREFETCH(c) do { const size_t ro = (size_t)(c) * 64 * 2048; \
            _Pragma("unroll") for (int i = 0; i < 4; ++i) { pq[i] = *(const GAS v4u*)(qsrc + ro + 64 * i); pk[i] = *(const GAS v4u*)(qsrc + ro + 1024 + 64 * i); } \
            pv = *(const GAS v4u*)(vsrc + ro); \
            po = *(const GAS v4u*)(osrc + ro); \
            pgi = gsrc[(size_t)(c) * 64 * 8]; pgf = gsrc[(size_t)(c) * 64 * 8 + 4]; } while (0)
        ML_PREFETCH(0);
        __syncthreads();
#pragma unroll 1
        for (int c = 0; c < SEQ / 64; ++c) {
            LAS unsigned char* TB = L + ML_TAB + (c & 1) * 2048;
            const float bsum = wave_scan_sum(pgf, lane);
            const float gg = pgi - bsum;
            const float mxs = wave_scan_max(gg, lane);
            const float mu = fmaxf(m_run, mxs), isc = __expf(m_run - mu), flo = __expf(-(bsum + mu));
            const float mu63 = __int_as_float(__builtin_amdgcn_readlane(__float_as_int(mu), 63)), b63 = __int_as_float(__builtin_amdgcn_readlane(__float_as_int(bsum), 63));
            const float wgt = __expf(gg - mu63), decay = __expf(m_run - mu63);
            m_run = b63 + mu63;
            if (w == 0) { *(LAS float*)(TB + T_G + 4 * lane) = gg; *(LAS float*)(TB + T_MU + 4 * lane) = mu; *(LAS float*)(TB + T_ISC + 4 * lane) = isc; *(LAS float*)(TB + T_FLO + 4 * lane) = flo;
                *(LAS unsigned short*)(L + ML_VWT + 64 * ML_VP + 2 * lane) = (unsigned short)f2bf(wgt); }
#pragma unroll
            for (int i = 0; i < 4; ++i) { *(LAS v4u*)(L + ML_QS + prow * ML_QP + pseg * 16 + 128 * i) = pq[i]; *(LAS v4u*)(L + ML_KS + prow * ML_QP + pseg * 16 + 128 * i) = pk[i]; }
            { float vf[8]; unpack8(pv, vf);
              const unsigned vr[4] = {pv.x, pv.y, pv.z, pv.w};
#pragma unroll
              for (int i = 0; i < 8; ++i) { *(LAS unsigned short*)(L + ML_VT + (8 * veg + i) * ML_VP + 2 * vs_) = (unsigned short)((i & 1) ? (vr[i >> 1] >> 16) : (vr[i >> 1] & 0xffffu));
                  *(LAS unsigned short*)(L + ML_VWT + (8 * veg + i) * ML_VP + 2 * vs_) = (unsigned short)f2bf(wgt * vf[i]); } }
            *(LAS v4u*)(L + ML_OG + (c & 1) * 64 * ML_VP + prow * ML_VP + pseg * 16) = po;
            if (c + 1 < SEQ / 64) ML_PREFETCH(c + 1);
            __syncthreads();
            if (c > 0) *(GAS v4u*)(odst + (size_t)(c - 1) * 64 * 2048) = *(const LAS v4u*)(L + ML_OT + prow * ML_VP + pseg * 16);
            {
                bf16x8 qfr[8];
#pragma unroll
                for (int ks = 0; ks < 8; ++ks) qfr[ks] = *(const LAS bf16x8*)(L + ML_QS + (16 * qtt + l15) * ML_QP + 64 * ks + 16 * kg);
                const int tq = 16 * qtt + l15; const float mu_t = *(const LAS float*)(TB + T_MU + 4 * tq);
                __builtin_amdgcn_sched_barrier(0);
#pragma unroll
                for (int si = 0; si < 2; ++si) {
                    const int st = si ? tB : tA; if (st < 0) break;
                    bf16x8 kf[8];
#pragma unroll
                    for (int ks = 0; ks < 8; ++ks) kf[ks] = *(const LAS bf16x8*)(L + ML_KS + (16 * st + l15) * ML_QP + 64 * ks + 16 * kg);
                    __builtin_amdgcn_sched_barrier(0);
                    f32x4v a = Z4;
#pragma unroll
                    for (int ks = 0; ks < 8; ++ks) a = MFMA16(kf[ks], qfr[ks], a);
                    __builtin_amdgcn_sched_barrier(0);
                    if (st < 4) {
                        const f32x4v g4 = *(const LAS f32x4v*)(TB + T_G + 4 * (16 * st + 4 * kg));
                        float sv[4];
#pragma unroll
                        for (int i = 0; i < 4; ++i) { const int s_ = 16 * st + 4 * kg + i; const float dd = __expf(g4[i] - mu_t); sv[i] = (s_ <= tq) ? a[i] * dd : 0.f; }
                        u32x2v pk2v; pk2v.x = cvtpk(sv[0], sv[1]); pk2v.y = cvtpk(sv[2], sv[3]);
                        *(LAS u32x2v*)(L + ML_SS + tq * ML_VP + 2 * (16 * st + 4 * kg)) = pk2v;
                    } else { if (kg == 0) *(LAS float*)(TB + T_QN + 4 * tq) = a[0]; }
                }
            }
            __syncthreads();
            f32x4v val[4], accD = Z4;
            {
                bf16x8 bc[4];
#pragma unroll
                for (int ks = 0; ks < 4; ++ks) { v4u p; p.x = cvtpk(Cacc[2 * ks][0], Cacc[2 * ks][1]); p.y = cvtpk(Cacc[2 * ks][2], Cacc[2 * ks][3]); p.z = cvtpk(Cacc[2 * ks + 1][0], Cacc[2 * ks + 1][1]); p.w = cvtpk(Cacc[2 * ks + 1][2], Cacc[2 * ks + 1][3]);
                    bc[ks] = __builtin_bit_cast(bf16x8, p); }
                const bf16x8 vb = *(const LAS bf16x8*)(L + ML_VT + (16 * e16 + l15) * ML_VP + 64 * hf + 16 * kg);
                const bf16x8 vd = *(const LAS bf16x8*)(L + ML_VT + (64 + l15) * ML_VP + 64 * hf + 16 * kg);
                bf16x8 sa[4];
#pragma unroll
                for (int tt = 0; tt < 4; ++tt) sa[tt] = *(const LAS bf16x8*)(L + ML_SS + (16 * tt + l15) * ML_VP + 64 * hf + 16 * kg);
                __builtin_amdgcn_sched_barrier(0);
#pragma unroll
                for (int tt = 0; tt < 4; ++tt) {
                    u32x2v qlo[4], qhi[4];
#pragma unroll
                    for (int ks = 0; ks < 4; ++ks) { const LAS unsigned char* qp = L + ML_QS + (16 * tt + l15) * ML_QP + 2 * (128 * hf + 32 * ks + 4 * kg); qlo[ks] = *(const LAS u32x2v*)qp; qhi[ks] = *(const LAS u32x2v*)(qp + 32); }
                    __builtin_amdgcn_sched_barrier(0);
                    f32x4v aB = Z4;
#pragma unroll
                    for (int ks = 0; ks < 4; ++ks) { const v4u qa = {qlo[ks].x, qlo[ks].y, qhi[ks].x, qhi[ks].y}; aB = MFMA16(__builtin_bit_cast(bf16x8, qa), bc[ks], aB); }
                    f32x4v aA = Z4;
                    if (hf == 0 || tt >= 2) { aA = MFMA16(sa[tt], vb, Z4); if (tt == e16) accD = MFMA16(sa[tt], vd, Z4); }
                    const f32x4v i4 = *(const LAS f32x4v*)(TB + T_ISC + 4 * (16 * tt + 4 * kg));
                    val[tt] = aA + i4 * aB;
                }
                const f32x4v s0 = hf ? val[0] : val[2], s1 = hf ? val[1] : val[3];
                *(LAS f32x4v*)(L + ML_RED + ((w * 2 + 0) * 64 + lane) * 16) = s0; *(LAS f32x4v*)(L + ML_RED + ((w * 2 + 1) * 64 + lane) * 16) = s1;
                if (l15 == 0) *(LAS f32x4v*)(TB + T_DP + 4 * (hf * 64 + 16 * e16 + 4 * kg)) = accD;
            }
            {
                bf16x8 vwb[2], vwn[2];
#pragma unroll
                for (int ks = 0; ks < 2; ++ks) { vwb[ks] = *(const LAS bf16x8*)(L + ML_VWT + (16 * e16 + l15) * ML_VP + 64 * ks + 16 * kg); vwn[ks] = *(const LAS bf16x8*)(L + ML_VWT + (64 + l15) * ML_VP + 64 * ks + 16 * kg); }
                nacc[0] = nacc[0] * decay; nacc[1] = nacc[1] * decay;
#pragma unroll
                for (int dh = 0; dh < 2; ++dh) {
                    bf16x8 ka[4][2];
#pragma unroll
                    for (int d4 = 0; d4 < 4; ++d4)
#pragma unroll
                        for (int ks = 0; ks < 2; ++ks) ka[d4][ks] = tr_pair(L + ML_KS + (32 * ks + 8 * kg + (l15 >> 2)) * ML_QP + 2 * (128 * hf + 16 * (4 * dh + d4) + 4 * (lane & 3)), 4 * ML_QP);
                    __builtin_amdgcn_sched_barrier(0);
#pragma unroll
                    for (int d4 = 0; d4 < 4; ++d4) { const int dt = 4 * dh + d4;
                        Cacc[dt] = Cacc[dt] * decay;
#pragma unroll
                        for (int ks = 0; ks < 2; ++ks) { Cacc[dt] = MFMA16(ka[d4][ks], vwb[ks], Cacc[dt]);
                            if ((dt >> 1) == e16) nacc[dt & 1] = MFMA16(ka[d4][ks], vwn[ks], nacc[dt & 1]); } }
                }
            }
            __syncthreads();
            if (l15 == 0) {
#pragma unroll
                for (int q2 = 0; q2 < 2; ++q2)
#pragma unroll
                    for (int i = 0; i < 4; ++i) *(LAS unsigned short*)(L + ML_KS + 64 * ML_QP + 2 * (128 * hf + 16 * (2 * e16 + q2) + 4 * kg + i)) = (unsigned short)f2bf(nacc[q2][i]);
            }
            {
                const f32x4v k0 = hf ? val[2] : val[0], k1 = hf ? val[3] : val[1];
                const f32x4v r0 = *(const LAS f32x4v*)(L + ML_RED + (((w ^ 4) * 2 + 0) * 64 + lane) * 16), r1 = *(const LAS f32x4v*)(L + ML_RED + (((w ^ 4) * 2 + 1) * 64 + lane) * 16);
                const f32x4v num[2] = {k0 + r0, k1 + r1};
#pragma unroll
                for (int q2 = 0; q2 < 2; ++q2) { const int t4 = 16 * (2 * hf + q2) + 4 * kg;
                    const f32x4v d0 = *(const LAS f32x4v*)(TB + T_DP + 4 * t4), d1 = *(const LAS f32x4v*)(TB + T_DP + 4 * (64 + t4)), i4 = *(const LAS f32x4v*)(TB + T_ISC + 4 * t4), q4 = *(const LAS f32x4v*)(TB + T_QN + 4 * t4), f4 = *(const LAS f32x4v*)(TB + T_FLO + 4 * t4);
#pragma unroll
                    for (int i = 0; i < 4; ++i) { const float den = d0[i] + d1[i] + i4[i] * q4[i]; const float hv = num[q2][i] * __builtin_amdgcn_rcpf(fmaxf(fabsf(den), f4[i]));
                        const float o = __uint_as_float(((unsigned)*(const LAS unsigned short*)(L + ML_OG + (c & 1) * 64 * ML_VP + (t4 + i) * ML_VP + 2 * (16 * e16 + l15))) << 16);
                        *(LAS unsigned short*)(L + ML_OT + (t4 + i) * ML_VP + 2 * (16 * e16 + l15)) = (unsigned short)f2bf(hv * __builtin_amdgcn_rcpf(1.0f + __expf(-o))); } }
            }
        }
#undef ML_PREFETCH
        __syncthreads();
        *(GAS v4u*)(odst + (size_t)(SEQ / 64 - 1) * 64 * 2048) = *(const LAS v4u*)(L + ML_OT + prow * ML_VP + pseg * 16);
        __syncthreads();
    }
}

__global__ void __launch_bounds__(NWAVES * 64, 2) fwd(Args args) {
    __shared__ __attribute__((aligned(16))) unsigned char lds[LDS_BYTES];
    Frame F;
    F.lds = (LAS unsigned char*)lds;
    F.MISC = (volatile LAS unsigned*)(F.lds + MISC_OFF);
    F.tid = threadIdx.x; F.lane = F.tid & 63; F.wave = __builtin_amdgcn_readfirstlane(F.tid >> 6);
    F.G = gridDim.x; { const int bx = blockIdx.x; F.vcu = (F.G % 8 == 0) ? (bx % 8) * (F.G / 8) + bx / 8 : bx; }
    unsigned char* ws = args.ws;
    F.ctl = (gu32*)(ws + WS_CTL);
    for (int u = F.tid; u < LDSCTL_BYTES / 4; u += NWAVES * 64) ((LAS unsigned*)(F.lds + LDSCTL_OFF))[u] = 0u;
    __syncthreads();
    const int lo = args.ph_lo, hi = args.ph_hi;
    XcdBarrier bar; bar.bar = (unsigned*)(F.ctl + CW_BAR) + args.li * XCD_BAR_WORDS; bar.x = 0; bar.st = nullptr;
    if (hi - lo > 1) bar = xcd_barrier_post((unsigned*)(F.ctl + CW_BAR) + args.li * XCD_BAR_WORDS, F.MISC + 8);
    if (hi - lo > 1 && F.tid == 0) F.MISC[12] = xb_add(&bar.bar[XB_CLAIM(bar.x)], 1u);
#define IN(k) (lo <= (k) && (k) < hi)
#define BOTH(k) (IN(k) && IN((k) + 1))
#define GRID_BAR_FULL() xcd_barrier(bar)
#define GRID_BAR() do { if (loc) xcd_barrier_local(bar); else xcd_barrier(bar); } while (0)
    bf16* H1 = (bf16*)args.out; bf16* QKC = (bf16*)args.out; bf16* CAT = (bf16*)(ws + WS_CAT);
    bf16* MQK = (bf16*)(ws + WS_MQK); bf16* MVO = (bf16*)(ws + WS_MVO); bf16* AQ = (bf16*)(ws + WS_AQ); bf16* AKV = (bf16*)(ws + WS_AKV); bf16* GMA = (bf16*)(ws + WS_GMA);
    bf16* TB = (bf16*)(ws + WS_T); bf16* X1B = (bf16*)(ws + WS_X1B); bf16* ACT = (bf16*)(ws + WS_ACT); float* SSQ2 = (float*)(ws + WS_SSQ2);

    if (IN(0)) { p0_prologue(F, args); if (BOTH(0)) GRID_BAR_FULL(); }
    int cpar = (int)blockIdx.x; bool loc = false;
    if (lo == 0 && hi - lo > 1 && F.MISC[10] != 0u) {
        const int xr = __builtin_amdgcn_readfirstlane((int)F.MISC[12]), xx = __builtin_amdgcn_readfirstlane((int)bar.x);
        F.vcu = xx * (F.G / 8) + xr; cpar = xr * 8 + xx; loc = true; }
    if (IN(1)) {
        pg8::Gemm g{H1, (const bf16*)(ws + WS_W1T), M, NPROJ, D, D, D}; pg8::StaticOrder S; S.init(M, NPROJ, F.G, cpar);
        pg8::EpiProj E{MQK, MVO, AQ, AKV, GMA, args.in[10]};
        pg8::gemm_phase<pg8::EpiProj, pg8::StaticOrder, PG8_ALIGN, PG8_SP2>(F.lds + RING_OFF, g, S, E);
        if (BOTH(1)) GRID_BAR();
    }
    if (IN(2)) { conv_phase(F, MQK, args.in[3], args.in[4], QKC); if (BOTH(2)) GRID_BAR(); }
    if (IN(3)) { mlstm_phase(F, QKC, MVO, (const float*)(ws + WS_GATES), CAT + 1024); if (BOTH(3)) GRID_BAR(); }
    if (IN(4)) {
        attn_phase(F, AQ, AKV, args.in[7], args.in[8], args.in[9], (const float2*)(ws + WS_ROPE), CAT, CAT + 1024);
        if (BOTH(4)) GRID_BAR_FULL(); }
    if (IN(5)) {
        pg8::Gemm g{CAT, (const bf16*)(ws + WS_WCAT), M, D, 2 * D, 2 * D, 2 * D}; pg8::StaticOrder S; S.init(M, D, F.G, cpar);
        pg8::EpiGate2 E{TB, GMA};
        pg8::gemm_phase<pg8::EpiGate2, pg8::StaticOrder, PG8_ALIGN, PG8_SP2>(F.lds + RING_OFF, g, S, E);
        if (BOTH(5)) GRID_BAR();
    }
    if (IN(6)) {
        pg8::Gemm g{TB, (const bf16*)(ws + WS_WOUT), M, D, D, D, D}; pg8::StaticOrder S; S.init(M, D, F.G, cpar);
        pg8::EpiX1 E{args.in[0], X1B, SSQ2, (LAS float*)(F.lds + XTRA_OFF), 0};
        pg8::gemm_phase<pg8::EpiX1, pg8::StaticOrder, PG8_ALIGN, PG8_SP2>(F.lds + RING_OFF, g, S, E);
        if (BOTH(6)) GRID_BAR();
    }
    if (IN(7)) {
        pg8::Gemm g{X1B, (const bf16*)(ws + WS_WFI), M, NFF2, D, D, D}; pg8::StaticOrder S; S.init(M, NFF2, F.G, cpar);
        pg8::EpiSwiGLU E{SSQ2, ACT, EPS};
        pg8::gemm_phase<pg8::EpiSwiGLU, pg8::StaticOrder, PG8_ALIGN, PG8_SP2>(F.lds + RING_OFF, g, S, E);
        if (BOTH(7)) GRID_BAR();
    }
    if (IN(8)) {
        pg8::Gemm g{ACT, (const bf16*)(ws + WS_WFO), M, D, DFF, DFF, DFF}; pg8::StaticOrder S; S.init(M, D, F.G, cpar);
        pg8::EpiOut E{X1B, args.out};
        pg8::gemm_phase<pg8::EpiOut, pg8::StaticOrder, PG8_ALIGN, PG8_SP2>(F.lds + RING_OFF, g, S, E);
    }
#undef IN
#undef BOTH
#undef GRID_BAR
}

extern "C" void kernel_launch(void* const* d_in, const int* in_sizes, int n_in, void* d_out, int out_size, void* d_ws, size_t ws_size, hipStream_t stream) {
    static int grid = 0;
    if (grid == 0) {
        if (n_in != 17 || in_sizes[0] != M * D || out_size != M * D || ws_size < WS_END) { fprintf(stderr, "kernel_launch: unexpected shapes / workspace (n_in %d, in0 %d, out %d, ws %zu)\n", n_in, n_in > 0 ? in_sizes[0] : -1, out_size, ws_size); grid = -1; return; }
        int dev = 0, cus = 0;
        if (hipGetDevice(&dev) != hipSuccess || hipDeviceGetAttribute(&cus, hipDeviceAttributeMultiprocessorCount, dev) != hipSuccess) { grid = -1; return; }
        grid = cus;
    }
    if (grid < 0) return;
    (void)hipMemsetAsync((char*)d_ws + WS_CTL, 0, CTL_ZERO_BYTES, stream);
    Args a{};
    for (int i = 0; i < 17; ++i) a.in[i] = (const float*)d_in[i];
    a.out = (float*)d_out; a.ws = (unsigned char*)d_ws;
    unsigned char* ws = (unsigned char*)d_ws;
    int nl = 0;
    auto run = [&](int lo, int hi) { a.ph_lo = lo; a.ph_hi = hi; a.li = nl++; hipLaunchKernelGGL(fwd, dim3(grid), dim3(NWAVES * 64), 0, stream, a); };
    run(0, 9);
}
```
